# Optimizing an MI355X kernel written in HIP

```python
import math
import jax, jax.numpy as jnp
from jax import lax
import numpy as np

D_MODEL = 1024
BATCH = 4
SEQ = 8192
DEPTH = 4

N_MIXERS = 2
N_SELF_HEADS = 12
N_MEM_HEADS = 4
HEAD_DIM = 64
SELF_WIDTH = N_SELF_HEADS * HEAD_DIM
MEM_WIDTH = N_MEM_HEADS * HEAD_DIM
MIX_WIDTH = SELF_WIDTH + MEM_WIDTH
N_MEM = 256
D_FF = -(-8 * D_MODEL // (3 * 256)) * 256
FOX_Q_BLOCK = 128
MOBA_BLOCK = 256
MOBA_TOPK = 3
MOBA_Q_CHUNK = 32
N_FOX_LAYERS = (DEPTH + 1) // 2
N_MOBA_LAYERS = DEPTH // 2
FOX_PROJ = 3 * SELF_WIDTH + N_SELF_HEADS + MEM_WIDTH
MOBA_PROJ = 3 * SELF_WIDTH + MEM_WIDTH
NEG = -1e30
RMS_EPS = 1e-6

kernel_name = "hybrid_fox_moba_memory_trunk"


def rms_norm(x, g):
    xf = x.astype(jnp.float32)
    y = xf * lax.rsqrt(jnp.mean(xf * xf, axis=-1, keepdims=True) + RMS_EPS)
    return (y * g.astype(jnp.float32)).astype(x.dtype)


def split_heads(t, n_heads):
    b, s, _ = t.shape
    return t.reshape(b, s, n_heads, HEAD_DIM).transpose(0, 2, 1, 3)


def merge_heads(t):
    b, h, s, d = t.shape
    return t.transpose(0, 2, 1, 3).reshape(b, s, h * d)


def alibi_slopes(n_heads):
    return 2.0 ** (-8.0 * jnp.arange(1, n_heads + 1, dtype=jnp.float32) / n_heads)


def fox_attention(q, k, v, log_f):
    B, H, S, Dh = q.shape
    F = jnp.cumsum(log_f, axis=-1)
    scale = Dh ** -0.5
    kpos = jnp.arange(S)

    def one_block(i):
        start = i * FOX_Q_BLOCK
        qb = lax.dynamic_slice_in_dim(q, start, FOX_Q_BLOCK, axis=2)
        Fq = lax.dynamic_slice_in_dim(F, start, FOX_Q_BLOCK, axis=2)
        tq = start + jnp.arange(FOX_Q_BLOCK)
        s = (jnp.einsum('bhqd,bhkd->bhqk', qb, k).astype(jnp.float32) * scale
             + Fq[..., :, None] - F[..., None, :])
        s = jnp.where(tq[:, None] >= kpos[None, :], s, NEG)
        p = jax.nn.softmax(s, axis=-1)
        return jnp.einsum('bhqk,bhkd->bhqd', p.astype(v.dtype), v)

    out = lax.map(one_block, jnp.arange(S // FOX_Q_BLOCK))
    return out.transpose(1, 2, 0, 3, 4).reshape(B, H, S, Dh)


def moba_attention(q, k, v, slopes):
    B, H, S, Dh = q.shape
    L = MOBA_BLOCK
    nb = -(-S // L)
    S_pad = nb * L
    K = min(MOBA_TOPK, nb)
    pad = [(0, 0), (0, 0), (0, S_pad - S), (0, 0)]
    qp, kp, vp = jnp.pad(q, pad), jnp.pad(k, pad), jnp.pad(v, pad)
    kb = kp.reshape(B, H, nb, L, Dh)
    vb = vp.reshape(B, H, nb, L, Dh)
    kmean = jnp.mean(kb.astype(jnp.float32), axis=3)
    scale = Dh ** -0.5
    blk_ids = jnp.arange(nb)
    bi = jnp.arange(B)[:, None, None, None]
    hi = jnp.arange(H)[None, :, None, None]
    sl = slopes[None, :, None, None]

    def one_chunk(c):
        start = c * MOBA_Q_CHUNK
        qc = lax.dynamic_slice_in_dim(qp, start, MOBA_Q_CHUNK, axis=2)
        tq = start + jnp.arange(MOBA_Q_CHUNK)
        own = start // L
        gate = jnp.einsum('bhqd,bhnd->bhqn', qc.astype(jnp.float32), kmean)
        gate = jnp.where(blk_ids < own, gate, NEG)
        _, idx = lax.top_k(gate, K)
        valid = idx < own
        ksel = kb[bi, hi, idx]
        vsel = vb[bi, hi, idx]
        s_sel = jnp.einsum('bhqd,bhqkld->bhqkl', qc, ksel).astype(jnp.float32) * scale
        kpos_sel = idx[..., None] * L + jnp.arange(L)
        dist_sel = (tq[None, None, :, None, None] - kpos_sel).astype(jnp.float32)
        s_sel = jnp.where(valid[..., None], s_sel - sl[..., None] * dist_sel, NEG)
        s_sel = s_sel.reshape(B, H, MOBA_Q_CHUNK, K * L)
        kown = lax.dynamic_slice_in_dim(kp, own * L, L, axis=2)
        vown = lax.dynamic_slice_in_dim(vp, own * L, L, axis=2)
        opos = own * L + jnp.arange(L)
        dist_own = (tq[:, None] - opos[None, :]).astype(jnp.float32)
        s_own = (jnp.einsum('bhqd,bhld->bhql', qc, kown).astype(jnp.float32) * scale
                 - sl * dist_own)
        s_own = jnp.where(dist_own >= 0, s_own, NEG)
        p = jax.nn.softmax(jnp.concatenate([s_sel, s_own], axis=-1), axis=-1)
        p_sel = p[..., :K * L].astype(v.dtype)
        p_own = p[..., K * L:].astype(v.dtype)
        vsel = vsel.reshape(B, H, MOBA_Q_CHUNK, K * L, Dh)
        return (jnp.einsum('bhqm,bhqmd->bhqd', p_sel, vsel)
                + jnp.einsum('bhql,bhld->bhqd', p_own, vown))

    out = lax.map(one_chunk, jnp.arange(S_pad // MOBA_Q_CHUNK))
    out = out.transpose(1, 2, 0, 3, 4).reshape(B, H, S_pad, Dh)
    return out[:, :, :S]


def memory_attention(qm, mk, mv):
    s = jnp.einsum('bhsd,bhnd->bhsn', qm, mk).astype(jnp.float32) * (HEAD_DIM ** -0.5)
    p = jax.nn.softmax(s, axis=-1)
    return jnp.einsum('bhsn,bhnd->bhsd', p.astype(mv.dtype), mv)


def setup_inputs(seed: int = 0) -> dict:
    key = jax.random.key(seed)
    ks = jax.random.split(key, 14)
    f32 = jnp.float32
    x = jax.random.normal(ks[0], (BATCH, SEQ, D_MODEL), f32)
    mem = jax.random.normal(ks[1], (BATCH, N_MEM, D_MODEL), f32)
    norm_mix = 1.0 + 0.02 * jax.random.normal(ks[2], (DEPTH, D_MODEL), f32)
    norm_mem = 1.0 + 0.02 * jax.random.normal(ks[3], (DEPTH, D_MODEL), f32)
    norm_ffn = 1.0 + 0.02 * jax.random.normal(ks[4], (DEPTH, D_MODEL), f32)
    norm_final = 1.0 + 0.02 * jax.random.normal(ks[5], (D_MODEL,), f32)
    w_in_fox = jax.random.normal(ks[6], (N_FOX_LAYERS, D_MODEL, FOX_PROJ), f32) * D_MODEL ** -0.5
    b_fgate = jax.random.uniform(ks[7], (N_FOX_LAYERS, N_SELF_HEADS), f32, 1.0, 4.0)
    w_in_moba = jax.random.normal(ks[8], (N_MOBA_LAYERS, D_MODEL, MOBA_PROJ), f32) * D_MODEL ** -0.5
    w_mem_kv = jax.random.normal(ks[9], (DEPTH, D_MODEL, 2 * MEM_WIDTH), f32) * D_MODEL ** -0.5
    w_out = jax.random.normal(ks[10], (DEPTH, MIX_WIDTH, D_MODEL), f32) * MIX_WIDTH ** -0.5
    w_gate_up = jax.random.normal(ks[11], (DEPTH, D_MODEL, 2 * D_FF), f32) * D_MODEL ** -0.5
    w_down = jax.random.normal(ks[12], (DEPTH, D_FF, D_MODEL), f32) * D_FF ** -0.5
    return {"x": x, "mem": mem, "norm_mix": norm_mix, "norm_mem": norm_mem,
            "norm_ffn": norm_ffn, "norm_final": norm_final, "w_in_fox": w_in_fox,
            "b_fgate": b_fgate, "w_in_moba": w_in_moba, "w_mem_kv": w_mem_kv,
            "w_out": w_out, "w_gate_up": w_gate_up, "w_down": w_down}


def reference(x, mem, norm_mix, norm_mem, norm_ffn, norm_final, w_in_fox, b_fgate,
              w_in_moba, w_mem_kv, w_out, w_gate_up, w_down):
    slopes = alibi_slopes(N_SELF_HEADS)
    h = x
    for i in range(DEPTH):
        xn = rms_norm(h, norm_mix[i])
        mn = rms_norm(mem, norm_mem[i])
        mkv = mn @ w_mem_kv[i]
        mk = split_heads(mkv[..., :MEM_WIDTH], N_MEM_HEADS)
        mv = split_heads(mkv[..., MEM_WIDTH:], N_MEM_HEADS)
        j = i // N_MIXERS
        if i % N_MIXERS == 0:
            proj = xn @ w_in_fox[j]
            q = split_heads(proj[..., :SELF_WIDTH], N_SELF_HEADS)
            k = split_heads(proj[..., SELF_WIDTH:2 * SELF_WIDTH], N_SELF_HEADS)
            v = split_heads(proj[..., 2 * SELF_WIDTH:3 * SELF_WIDTH], N_SELF_HEADS)
            f_logit = proj[..., 3 * SELF_WIDTH:3 * SELF_WIDTH + N_SELF_HEADS]
            qm = split_heads(proj[..., 3 * SELF_WIDTH + N_SELF_HEADS:], N_MEM_HEADS)
            log_f = jax.nn.log_sigmoid(f_logit.astype(jnp.float32)
                                       + b_fgate[j].astype(jnp.float32))
            self_out = fox_attention(q, k, v, log_f.transpose(0, 2, 1))
        else:
            proj = xn @ w_in_moba[j]
            q = split_heads(proj[..., :SELF_WIDTH], N_SELF_HEADS)
            k = split_heads(proj[..., SELF_WIDTH:2 * SELF_WIDTH], N_SELF_HEADS)
            v = split_heads(proj[..., 2 * SELF_WIDTH:3 * SELF_WIDTH], N_SELF_HEADS)
            qm = split_heads(proj[..., 3 * SELF_WIDTH:], N_MEM_HEADS)
            self_out = moba_attention(q, k, v, slopes)
        mem_out = memory_attention(qm, mk, mv)
        heads = jnp.concatenate([merge_heads(self_out), merge_heads(mem_out)], axis=-1)
        h = h + heads @ w_out[i]
        hn = rms_norm(h, norm_ffn[i])
        gu = hn @ w_gate_up[i]
        h = h + (jax.nn.silu(gu[..., :D_FF]) * gu[..., D_FF:]) @ w_down[i]
    return rms_norm(h, norm_final)
```

```cpp
#include <hip/hip_runtime.h>
#include <cstdio>
#include <cstdint>

constexpr int BATCH = 4, T = 8192, D = 1024, M = BATCH * T;
constexpr int NSH = 12, NMH = 4, HD = 64, SELFW = NSH * HD, MEMW = NMH * HD;
constexpr int NMEM = 256, MROWS = BATCH * NMEM;
constexpr int DFF = 2816, DEPTH = 4;
constexpr int FOXP = 3 * SELFW + NSH + MEMW;
constexpr int MOBAP = 3 * SELFW + MEMW;
constexpr int NBLK = T / 256;
constexpr float RMS_EPS = 1e-6f;
constexpr float LOG2E = 1.4426950408889634f;
constexpr float C2 = 0.125f * LOG2E;

constexpr size_t MiB = 1u << 20;
constexpr size_t WS_CTL = 0, CTL_ZERO_BYTES = 2 * MiB;
constexpr size_t WS_KMEAN = 1 * MiB;
constexpr size_t KMEAN_STRIDE = 512 * 1024;
constexpr size_t WS_SSQA = 2 * MiB, WS_SSQB = 4 * MiB;
constexpr size_t WS_RSTDM = 6 * MiB;
constexpr size_t WS_LF = 7 * MiB;
constexpr size_t WS_G = 8 * MiB + 512 * 1024;
constexpr size_t WS_MKV = 10 * MiB;
constexpr size_t WS_MEMB = 14 * MiB;
constexpr size_t WS_W = 16 * MiB;
constexpr size_t WS_HB = 116 * MiB;
constexpr size_t WS_Q = 180 * MiB, WS_K = 228 * MiB, WS_V = 276 * MiB, WS_QM = 324 * MiB, WS_HEADS = 340 * MiB;
constexpr size_t WS_ACT = 180 * MiB;
constexpr size_t WS_END = 404 * MiB;

typedef unsigned short bf16;
__device__ __forceinline__ float bf2f(bf16 v) { return __uint_as_float(((unsigned)v) << 16); }
__device__ __forceinline__ bf16 f2bf(float f) { unsigned u = __float_as_uint(f); return (bf16)((u + 0x7fffu + ((u >> 16) & 1u)) >> 16); }
__device__ __forceinline__ float wave_sum(float v) {
#pragma unroll
    for (int o = 1; o < 64; o <<= 1) v += __shfl_xor(v, o);
    return v;
}

namespace pg8 {
#define PG8_LAS __attribute__((address_space(3)))
typedef unsigned short bf16_t;
typedef short bf16x8 __attribute__((ext_vector_type(8)));
typedef float f32x4 __attribute__((ext_vector_type(4)));
typedef unsigned u32x4 __attribute__((ext_vector_type(4)));
constexpr int BM = 256, BK = 64, HALF = 128, HTB = HALF * BK * 2  , STAGE_BYTES = 8 * HTB, NXCD = 8, WGM = 8;

__host__ __device__ __forceinline__ int lds_byte(int r, int c) { const int st = (r >> 4) * 2 + (c >> 5), rr = r & 15, cc = c & 31, ob = rr * 64 + cc * 2; return st * 1024 + (ob ^ (((ob >> 9) & 1) << 5)); }
__host__ __device__ __forceinline__ void stage_rc(int b, int& R, int& C) { const int st = b / 1024, sb = b % 1024, swz = sb ^ (((sb >> 9) & 1) << 5); R = (st >> 1) * 16 + swz / 64; C = (st & 1) * 32 + (swz % 64) / 2; }
__host__ __device__ __forceinline__ int perm32(int rho) { const int n = rho >> 4, i = rho & 15; return 8 * (i >> 2) + 4 * n + (i & 3); }

struct Unit { int pm, pn; };
struct Gemm { const bf16_t* A; const bf16_t* Bt; int M, N, K; };

struct StaticOrder {
    int nM, nN, nwg, G, c;
    __host__ __device__ void init(int M, int N, int G_, int c_) { nM = M / BM; nN = N / BM; nwg = nM * nN; G = G_; c = c_; }
    __host__ __device__ bool next(int i, Unit& u) const {
        const long L = (long)i * G + c; if (L >= nwg) return false;
        int wgid = (int)L; { const int q = nwg / NXCD, r = nwg % NXCD, xcd = wgid % NXCD, off = wgid / NXCD; wgid = (xcd < r ? xcd * (q + 1) : r * (q + 1) + (xcd - r) * q) + off; }
        const int nig = WGM * nN, gid = wgid / nig, fm = gid * WGM, gsz = (nM - fm) < WGM ? (nM - fm) : WGM;
        u.pm = fm + ((wgid % nig) % gsz); u.pn = (wgid % nig) / gsz; return true;
    }
    __device__ __forceinline__ void a_ready(const Unit&) const {}
    __device__ __forceinline__ void done(const Unit&) const {}
};

__device__ __forceinline__ unsigned cvt_pk_bf16(float lo, float hi) { unsigned r; asm volatile("v_cvt_pk_bf16_f32 %0, %1, %2" : "=v"(r) : "v"(lo), "v"(hi)); return r; }
typedef float f32x2 __attribute__((ext_vector_type(2)));
constexpr float kEps = 1e-6f, kLog2e = 1.4426950408889634f, kC2 = 0.125f * 1.4426950408889634f;
__device__ __forceinline__ void row_rstd(const float* ssq, int row0, int fq, float (&rs)[2][4]) {
#pragma unroll
    for (int ai = 0; ai < 2; ++ai)
#pragma unroll
        for (int m = 0; m < 4; ++m) { const f32x4 p = *(const f32x4*)(ssq + (size_t)(row0 + ai * HALF + m * 16) * 16 + 4 * fq);
            float s = (p[0] + p[1]) + (p[2] + p[3]); s += __shfl_xor(s, 16); s += __shfl_xor(s, 32); rs[ai][m] = rsqrtf(s * (1.0f / 1024.0f) + kEps); }
}
__device__ __forceinline__ u32x4 pack8(const f32x4 v0, const f32x4 v1) { u32x4 w; w.x = cvt_pk_bf16(v0[0], v0[1]); w.y = cvt_pk_bf16(v0[2], v0[3]); w.z = cvt_pk_bf16(v1[0], v1[1]); w.w = cvt_pk_bf16(v1[2], v1[3]); return w; }

struct EpiProj {
    static constexpr bool PERM = true, AFTER_DRAIN = false, CINIT = false;
    bf16_t *Q, *K, *V, *QM; float* kmean; const float* ssq; float* nmax;
    __device__ __forceinline__ void operator()(const f32x4 (&acc)[2][2][4][2], const Unit& u, int wr, int wc, int fr, int fq) const {
        const int row0 = u.pm * BM + wr * 64 + fr, pn = u.pn;
        float rs[2][4]; row_rstd(ssq, row0, fq, rs);
        if (pn <= 9) {
            bf16_t* base; int ld = 768, coff; float sc = 1.f;
            if (pn < 3) { base = Q; coff = pn * 256; sc = kC2; } else if (pn < 6) { base = K; coff = (pn - 3) * 256; } else if (pn < 9) { base = V; coff = (pn - 6) * 256; } else { base = QM; ld = 256; coff = 0; sc = kC2; }
            const int col0 = coff + wc * 32 + 8 * fq; float mx[2] = {0.f, 0.f};
#pragma unroll
            for (int ai = 0; ai < 2; ++ai)
#pragma unroll
                for (int m = 0; m < 4; ++m) { const int row = row0 + ai * HALF + m * 16; bf16_t* rowp = base + (size_t)row * ld + col0; const float f = rs[ai][m] * sc;
#pragma unroll
                    for (int bj = 0; bj < 2; ++bj) { const f32x4 v0 = acc[ai][bj][m][0] * f, v1 = acc[ai][bj][m][1] * f; *(u32x4*)(rowp + bj * HALF) = pack8(v0, v1);
                        if (pn < 6) { float q = (v0[0] * v0[0] + v0[1] * v0[1]) + (v0[2] * v0[2] + v0[3] * v0[3]) + (v1[0] * v1[0] + v1[1] * v1[1]) + (v1[2] * v1[2] + v1[3] * v1[3]);
                            q += __shfl_xor(q, 16); q += __shfl_xor(q, 32); mx[bj] = fmaxf(mx[bj], q); } } }
            if (pn < 6) {
#pragma unroll
                for (int bj = 0; bj < 2; ++bj) { float v = mx[bj]; v = fmaxf(v, __shfl_xor(v, 1)); v = fmaxf(v, __shfl_xor(v, 2)); v = fmaxf(v, __shfl_xor(v, 4)); v = fmaxf(v, __shfl_xor(v, 8));
                    if (fr == 0 && fq == 0) atomicMax((unsigned*)nmax + ((size_t)(u.pm >> 5) * 12 + (coff >> 6) + bj * 2 + (wc >> 1)) * 4 + (pn < 3 ? 0 : 2) + (wc & 1), __float_as_uint(v)); } }
            if (kmean && pn >= 3 && pn < 6) {
#pragma unroll
                for (int bj = 0; bj < 2; ++bj)
#pragma unroll
                    for (int n = 0; n < 2; ++n) { f32x4 s = {0.f, 0.f, 0.f, 0.f};
#pragma unroll
                        for (int ai = 0; ai < 2; ++ai)
#pragma unroll
                            for (int m = 0; m < 4; ++m) s += acc[ai][bj][m][n] * rs[ai][m];
#pragma unroll
                        for (int j = 0; j < 4; ++j) { float t = s[j]; t += __shfl_xor(t, 1); t += __shfl_xor(t, 2); t += __shfl_xor(t, 4); t += __shfl_xor(t, 8);
                            if (fr == 0) atomicAdd(kmean + (size_t)u.pm * 768 + col0 + bj * HALF + 4 * n + j, t * (1.0f / 256.0f)); } }
            }
        }
    }
};
struct EpiMkv {
    static constexpr bool PERM = true, AFTER_DRAIN = false, CINIT = false;
    bf16_t* MKV; const float* rstd;
    __device__ __forceinline__ void operator()(const f32x4 (&acc)[2][2][4][2], const Unit& u, int wr, int wc, int fr, int fq) const {
        const int row0 = u.pm * BM + wr * 64 + fr, col0 = u.pn * BM + wc * 32 + 8 * fq;
#pragma unroll
        for (int ai = 0; ai < 2; ++ai)
#pragma unroll
            for (int m = 0; m < 4; ++m) { const int row = row0 + ai * HALF + m * 16; const float f = rstd[row]; bf16_t* rowp = MKV + (size_t)row * 2048 + col0;
#pragma unroll
                for (int bj = 0; bj < 2; ++bj) *(u32x4*)(rowp + bj * HALF) = pack8(acc[ai][bj][m][0] * f, acc[ai][bj][m][1] * f); }
    }
};
struct EpiRes {
    static constexpr bool PERM = true, AFTER_DRAIN = false, CINIT = true;
    bf16_t* hb; float* ssq;
    __device__ __forceinline__ void cinit(f32x4 (&acc)[2][2][4][2], const Unit& u, int wr, int wc, int fr, int fq) const {
        const int row0 = u.pm * BM + wr * 64 + fr, col0 = u.pn * BM + wc * 32 + 8 * fq;
#pragma unroll
        for (int ai = 0; ai < 2; ++ai)
#pragma unroll
            for (int m = 0; m < 4; ++m)
#pragma unroll
                for (int bj = 0; bj < 2; ++bj) { const u32x4 o = *(const u32x4*)(hb + (size_t)(row0 + ai * HALF + m * 16) * 1024 + col0 + bj * HALF);
                    acc[ai][bj][m][0] = (f32x4){__uint_as_float(o.x << 16), __uint_as_float(o.x & 0xffff0000u), __uint_as_float(o.y << 16), __uint_as_float(o.y & 0xffff0000u)};
                    acc[ai][bj][m][1] = (f32x4){__uint_as_float(o.z << 16), __uint_as_float(o.z & 0xffff0000u), __uint_as_float(o.w << 16), __uint_as_float(o.w & 0xffff0000u)}; }
    }
    __device__ __forceinline__ void operator()(const f32x4 (&acc)[2][2][4][2], const Unit& u, int wr, int wc, int fr, int fq) const {
        const int row0 = u.pm * BM + wr * 64 + fr, col0 = u.pn * BM + wc * 32 + 8 * fq;
#pragma unroll
        for (int ai = 0; ai < 2; ++ai)
#pragma unroll
            for (int m = 0; m < 4; ++m) { const int row = row0 + ai * HALF + m * 16; const size_t off = (size_t)row * 1024 + col0; float s = 0.f;
#pragma unroll
                for (int bj = 0; bj < 2; ++bj) { const f32x4 v0 = acc[ai][bj][m][0], v1 = acc[ai][bj][m][1];
                    *(u32x4*)(hb + off + bj * HALF) = pack8(v0, v1);
                    s += (v0[0] * v0[0] + v0[1] * v0[1]) + (v0[2] * v0[2] + v0[3] * v0[3]) + (v1[0] * v1[0] + v1[1] * v1[1]) + (v1[2] * v1[2] + v1[3] * v1[3]); }
                s += __shfl_xor(s, 16); s += __shfl_xor(s, 32);
                if (fq == 0) ssq[(size_t)row * 16 + u.pn * 4 + wc] = s; }
    }
};
struct EpiSwi {
    static constexpr bool PERM = true, AFTER_DRAIN = false, CINIT = false;
    bf16_t* ACT; const float* ssq;
    __device__ __forceinline__ void operator()(const f32x4 (&acc)[2][2][4][2], const Unit& u, int wr, int wc, int fr, int fq) const {
        const int row0 = u.pm * BM + wr * 64 + fr, col0 = u.pn * HALF + wc * 32 + 8 * fq;
        float rs[2][4]; row_rstd(ssq, row0, fq, rs);
#pragma unroll
        for (int ai = 0; ai < 2; ++ai)
#pragma unroll
            for (int m = 0; m < 4; ++m) { const float f = rs[ai][m]; f32x4 a[2];
#pragma unroll
                for (int n = 0; n < 2; ++n) { const f32x4 g = acc[ai][0][m][n] * f, up = acc[ai][1][m][n] * f;
#pragma unroll
                    for (int j = 0; j < 4; ++j) a[n][j] = g[j] * __builtin_amdgcn_rcpf(1.0f + __builtin_amdgcn_exp2f(-kLog2e * g[j])) * up[j]; }
                *(u32x4*)(ACT + (size_t)(row0 + ai * HALF + m * 16) * 2816 + col0) = pack8(a[0], a[1]); }
    }
};


template <class Epi, class Sched, bool ALIGN_EPI = false, bool SP2 = false>
__device__ __forceinline__ void gemm_phase(PG8_LAS unsigned char* lds, const Gemm g, const Sched& S, const Epi& E) {
    int tid_ = threadIdx.x; asm volatile("" : "+v"(tid_));
    const int tid = tid_, wid = __builtin_amdgcn_readfirstlane(tid >> 6), lane = tid & 63, wr = wid >> 2, wc = wid & 3, fr = lane & 15, fq = lane >> 4;
    const int K = g.K, nt = K / BK;
    unsigned voffA[2], voffB[2];
#pragma unroll
    for (int i = 0; i < 2; ++i) { int R, C; stage_rc(tid * 16 + i * 8192, R, C); const int Rb = Epi::PERM ? ((R & ~31) + perm32(R & 31)) : R;
        voffA[i] = (unsigned)(R * K + C) * 2u; voffB[i] = (unsigned)(Rb * K + C) * 2u; }
    const size_t kstep = (size_t)(BK * 2);
    const size_t hstep = (size_t)HALF * K * 2;
    const size_t tstep = 2 * hstep;
    const unsigned ldsw = (unsigned)wid * 1024u;
    const int aoff = lds_byte(wr * 64 + fr, fq * 8), boff = lds_byte(wc * 32 + fr, fq * 8);
#define PG8_SA(b, h) (((b) * 2 + (h)) * HTB)
#define PG8_SB(b, h) ((4 + (b) * 2 + (h)) * HTB)
#define PG8_STAGE(bufoff, gbase, voff) do { _Pragma("unroll") for (int _i = 0; _i < 2; ++_i) \
        __builtin_amdgcn_global_load_lds((const unsigned*)((const char*)(gbase) + (voff)[_i]), (PG8_LAS unsigned*)(lds + (bufoff) + ldsw + _i * 8192), 16, 0, 0); } while (0)
#define PG8_LDA(dst, b, h) do { _Pragma("unroll") for (int m = 0; m < 4; ++m) _Pragma("unroll") for (int k = 0; k < 2; ++k) dst[m][k] = *(const PG8_LAS bf16x8*)(lds + PG8_SA(b, h) + aoff + m * 2048 + k * 1024); } while (0)
#define PG8_LDB(dst, b, h) do { _Pragma("unroll") for (int n = 0; n < 2; ++n) _Pragma("unroll") for (int k = 0; k < 2; ++k) dst[n][k] = *(const PG8_LAS bf16x8*)(lds + PG8_SB(b, h) + boff + n * 2048 + k * 1024); } while (0)
#define PG8_MMA(ai, bj, At, Bt) do { __builtin_amdgcn_s_setprio(1); _Pragma("unroll") for (int m = 0; m < 4; ++m) _Pragma("unroll") for (int n = 0; n < 2; ++n) _Pragma("unroll") for (int k = 0; k < 2; ++k) \
        acc[ai][bj][m][n] = __builtin_amdgcn_mfma_f32_16x16x32_bf16(Bt[n][k], At[m][k], acc[ai][bj][m][n], 0, 0, 0); __builtin_amdgcn_s_setprio(0); } while (0)
#define PG8_WAIT_V(n) asm volatile("s_waitcnt vmcnt(" #n ")" ::: "memory")
#define PG8_WAIT_L(n) asm volatile("s_waitcnt lgkmcnt(" #n ")" ::: "memory")
#define PG8_BAR __builtin_amdgcn_s_barrier()
#define PG8_SCHED __builtin_amdgcn_sched_barrier(0)
    Unit cur, nxt; int ui = 0;
    if (!S.next(0, cur)) return;
    f32x4 acc[2][2][4][2];
#pragma unroll
    for (int a = 0; a < 2; ++a)
#pragma unroll
        for (int b = 0; b < 2; ++b)
#pragma unroll
            for (int m = 0; m < 4; ++m)
#pragma unroll
                for (int n = 0; n < 2; ++n) acc[a][b][m][n] = (f32x4){0.f, 0.f, 0.f, 0.f};
    if constexpr (Epi::CINIT) E.cinit(acc, cur, wr, wc, fr, fq);
    bf16x8 At[4][2], B0[2][2], B1[2][2];
    const char* cA = (const char*)g.A + (size_t)cur.pm * tstep; const char* cB = (const char*)g.Bt + (size_t)cur.pn * tstep;
    S.a_ready(cur);
    if constexpr (SP2) {
        PG8_STAGE(PG8_SB(0, 0), cB, voffB); PG8_STAGE(PG8_SB(0, 1), cB + hstep, voffB); PG8_STAGE(PG8_SA(0, 0), cA, voffA); PG8_STAGE(PG8_SA(0, 1), cA + hstep, voffA);
        if (wr == 1) PG8_BAR;
        PG8_WAIT_V(2); PG8_BAR;
        PG8_STAGE(PG8_SB(1, 0), cB + kstep, voffB); PG8_STAGE(PG8_SA(1, 0), cA + kstep, voffA); PG8_STAGE(PG8_SB(1, 1), cB + hstep + kstep, voffB);
        PG8_WAIT_V(6); PG8_BAR;
    } else {
        PG8_STAGE(PG8_SB(0, 0), cB, voffB); PG8_STAGE(PG8_SA(0, 0), cA, voffA); PG8_STAGE(PG8_SB(0, 1), cB + hstep, voffB); PG8_STAGE(PG8_SA(0, 1), cA + hstep, voffA);
        if (wr == 1) PG8_BAR;
        PG8_WAIT_V(4); PG8_BAR;
        PG8_STAGE(PG8_SB(1, 0), cB + kstep, voffB); PG8_STAGE(PG8_SA(1, 0), cA + kstep, voffA); PG8_STAGE(PG8_SB(1, 1), cB + hstep + kstep, voffB);
        PG8_WAIT_V(6); PG8_BAR;
    }
    for (;;) {
        const bool has_next = S.next(ui + 1, nxt);
        const char* nA = has_next ? (const char*)g.A + (size_t)nxt.pm * tstep : cA; const char* nB = has_next ? (const char*)g.Bt + (size_t)nxt.pn * tstep : cB;
        for (int t = 0; t < nt; t += 2) {
            const bool last = (t == nt - 2);
            const char* a1 = cA + (size_t)(t + 1) * kstep;
            const char* a2 = last ? nA : cA + (size_t)(t + 2) * kstep; const char* b2 = last ? nB : cB + (size_t)(t + 2) * kstep;
            const char* a3 = a2 + kstep; const char* b3 = b2 + kstep;
            if (last && has_next) S.a_ready(nxt);
            if constexpr (SP2) {
            PG8_LDB(B0, 0, 0); PG8_LDB(B1, 0, 1); PG8_SCHED; PG8_LDA(At, 0, 0); PG8_STAGE(PG8_SA(1, 1), a1 + hstep, voffA);
            PG8_WAIT_V(8); PG8_WAIT_L(0); PG8_BAR; PG8_MMA(0, 0, At, B0); PG8_MMA(0, 1, At, B1); PG8_BAR; PG8_SCHED;
            PG8_LDA(At, 0, 1); PG8_STAGE(PG8_SB(0, 0), b2, voffB); PG8_STAGE(PG8_SB(0, 1), b2 + hstep, voffB); PG8_STAGE(PG8_SA(0, 0), a2, voffA);
            PG8_WAIT_V(8); PG8_WAIT_L(0); PG8_BAR; PG8_MMA(1, 0, At, B0); PG8_MMA(1, 1, At, B1); PG8_BAR; PG8_SCHED;
            PG8_LDB(B0, 1, 0); PG8_LDB(B1, 1, 1); PG8_SCHED; PG8_LDA(At, 1, 0); PG8_STAGE(PG8_SA(0, 1), a2 + hstep, voffA);
            PG8_WAIT_V(8); PG8_WAIT_L(0); PG8_BAR; PG8_MMA(0, 0, At, B0); PG8_MMA(0, 1, At, B1); PG8_BAR; PG8_SCHED;
            PG8_LDA(At, 1, 1); PG8_STAGE(PG8_SB(1, 0), b3, voffB); PG8_STAGE(PG8_SB(1, 1), b3 + hstep, voffB); PG8_STAGE(PG8_SA(1, 0), a3, voffA);
            PG8_WAIT_V(8); PG8_WAIT_L(0); PG8_BAR; PG8_MMA(1, 0, At, B0); PG8_MMA(1, 1, At, B1); PG8_BAR; PG8_SCHED;
            } else {
            PG8_LDB(B0, 0, 0); PG8_SCHED; PG8_LDA(At, 0, 0); PG8_STAGE(PG8_SA(1, 1), a1 + hstep, voffA);
            PG8_WAIT_L(8); PG8_BAR; PG8_WAIT_L(0); PG8_MMA(0, 0, At, B0); PG8_BAR; PG8_SCHED;
            PG8_LDB(B1, 0, 1); PG8_STAGE(PG8_SB(0, 0), b2, voffB);
            PG8_BAR; PG8_WAIT_L(0); PG8_MMA(0, 1, At, B1); PG8_BAR;
            PG8_LDA(At, 0, 1); PG8_STAGE(PG8_SA(0, 0), a2, voffA);
            PG8_BAR; PG8_WAIT_L(0); PG8_MMA(1, 0, At, B0); PG8_BAR; PG8_SCHED;
            PG8_STAGE(PG8_SB(0, 1), b2 + hstep, voffB);
            PG8_WAIT_V(6); PG8_BAR; PG8_MMA(1, 1, At, B1); PG8_BAR;
            PG8_LDB(B0, 1, 0); PG8_SCHED; PG8_LDA(At, 1, 0); PG8_STAGE(PG8_SA(0, 1), a2 + hstep, voffA);
            PG8_WAIT_L(8); PG8_BAR; PG8_WAIT_L(0); PG8_MMA(0, 0, At, B0); PG8_BAR; PG8_SCHED;
            PG8_LDB(B1, 1, 1); PG8_STAGE(PG8_SB(1, 0), b3, voffB);
            PG8_BAR; PG8_WAIT_L(0); PG8_MMA(0, 1, At, B1); PG8_BAR;
            PG8_LDA(At, 1, 1); PG8_STAGE(PG8_SA(1, 0), a3, voffA);
            PG8_BAR; PG8_WAIT_L(0); PG8_MMA(1, 0, At, B0); PG8_BAR; PG8_SCHED;
            PG8_STAGE(PG8_SB(1, 1), b3 + hstep, voffB);
            PG8_WAIT_V(6); PG8_BAR; PG8_MMA(1, 1, At, B1); PG8_BAR;
            }
        }
        if constexpr (ALIGN_EPI) { if (wr == 0) PG8_BAR; }
        if constexpr (!Epi::AFTER_DRAIN) { E(acc, cur, wr, wc, fr, fq); S.done(cur); }
        if (!has_next) break;
#pragma unroll
        for (int a = 0; a < 2; ++a)
#pragma unroll
            for (int b = 0; b < 2; ++b)
#pragma unroll
                for (int m = 0; m < 4; ++m)
#pragma unroll
                    for (int n = 0; n < 2; ++n) acc[a][b][m][n] = (f32x4){0.f, 0.f, 0.f, 0.f};
        cur = nxt; cA = nA; cB = nB; ++ui;
        if constexpr (Epi::CINIT) E.cinit(acc, cur, wr, wc, fr, fq);
        if constexpr (ALIGN_EPI) { if (wr == 1) PG8_BAR; }
    }
    PG8_WAIT_V(0);
    if constexpr (!ALIGN_EPI) { if (wr == 0) PG8_BAR; }
    PG8_BAR;
    if constexpr (Epi::AFTER_DRAIN) { E.fused(acc, cur, wr, wc, fr, fq, lds, wid, lane); S.done(cur); }
#undef PG8_SA
#undef PG8_SB
#undef PG8_STAGE
#undef PG8_LDA
#undef PG8_LDB
#undef PG8_MMA
#undef PG8_WAIT_V
#undef PG8_WAIT_L
#undef PG8_BAR
#undef PG8_SCHED
}
}

namespace attn_body {
using bf16=unsigned short;
using bf16x8=__attribute__((ext_vector_type(8)))short;
using s16x4=__attribute__((ext_vector_type(4)))short;
using f32x16=__attribute__((ext_vector_type(16)))float;
using f32x4=__attribute__((ext_vector_type(4)))float;
using u32x4=__attribute__((ext_vector_type(4)))unsigned;
constexpr int D=64;
constexpr int NW=8,QBLK=32,QB=QBLK*NW,KVBLK=64;
__device__ __forceinline__ int crow(int r,int hi){return (r&3)+8*(r>>2)+4*hi;}
#define SBAR() __builtin_amdgcn_sched_barrier(0)
__device__ __forceinline__ void cmask(f32x16&p0,f32x16&p1,int jb,int qrel,int hi){
  const float NEG=-INFINITY; int kb=64*jb+4*hi;
  #pragma unroll
  for(int r=0;r<16;++r){int kv=kb+(r&3)+8*(r>>2); if(kv>qrel)p0[r]=NEG; if(kv+32>qrel)p1[r]=NEG;}
}
constexpr int NSLOT=3, SLOTB=8192;
constexpr int LDS_K=0, LDS_V=NSLOT*SLOTB, LDS_WS=2*NSLOT*SLOTB, LDS_OST=LDS_WS+NW*64*4, LDS_BYTES=LDS_OST+NW*4096;
constexpr int GT_OFF=86016, SEL_OFF=GT_OFF+32768, KM_OFF=SEL_OFF+1024, RED_OFF=KM_OFF+8192, BASE_OFF=RED_OFF+128, CNTL_OFF=BASE_OFF+128, ATTN_LDS_END=CNTL_OFF+128, RES_GT_OFF=100352, ALLT_OFF=102400;
__device__ __forceinline__ void glds16(const void*gsrc,unsigned lds_dst){unsigned keep;
  asm volatile("s_mov_b32 %0, m0\n\ts_mov_b32 m0, %2\n\ts_nop 0\n\tglobal_load_lds_dwordx4 %1, off\n\ts_mov_b32 m0, %0":"=&s"(keep):"v"(gsrc),"s"(lds_dst):"memory");}
__device__ __forceinline__ float max3f(float a,float b,float c){float r;asm("v_max3_f32 %0, %1, %2, %3":"=v"(r):"v"(a),"v"(b),"v"(c));return r;}
__device__ __forceinline__ float max2f(float a,float b){float r;asm("v_max_f32_e32 %0, %1, %2":"=v"(r):"v"(a),"v"(b));return r;}
__device__ __forceinline__ float fadd_s(float a,float b){float r;asm("v_add_f32_e32 %0, %1, %2":"=v"(r):"v"(a),"v"(b));return r;}
__device__ __forceinline__ float fsub_s(float a,float b){float r;asm("v_sub_f32_e32 %0, %1, %2":"=v"(r):"v"(a),"v"(b));return r;}
typedef float f32x2_t __attribute__((ext_vector_type(2))); typedef __bf16 bf16x2_t __attribute__((ext_vector_type(2)));
__device__ __forceinline__ unsigned cvtpk_s(float lo,float hi){f32x2_t v={lo,hi};bf16x2_t b=__builtin_convertvector(v,bf16x2_t);return __builtin_bit_cast(unsigned,b);}
#define WAIT_BAR(N) asm volatile("s_waitcnt vmcnt(" #N ") lgkmcnt(0)\n\ts_barrier":::"memory")

__device__ __forceinline__ void qkt(f32x16&p0,f32x16&p1,const char*Kslot,const bf16x8*qr,int r32,int hi){
  const char*kb=Kslot+hi*1024+r32*16;
  #pragma unroll
  for(int d0=0;d0<4;++d0){
    const bf16x8 b0=*reinterpret_cast<const bf16x8*>(kb+d0*2048);
    const bf16x8 b1=*reinterpret_cast<const bf16x8*>(kb+d0*2048+512);
    p0=__builtin_amdgcn_mfma_f32_32x32x16_bf16(b0,qr[d0],p0,0,0,0);p1=__builtin_amdgcn_mfma_f32_32x32x16_bf16(b1,qr[d0],p1,0,0,0);}
}
typedef __attribute__((address_space(3))) const char* lds_cptr;
typedef short v4i16_t __attribute__((ext_vector_type(4)));
__device__ __forceinline__ void kload8(bf16x8*kf,lds_cptr kp){
  kf[0]=*(const __attribute__((address_space(3))) bf16x8*)(kp);      kf[1]=*(const __attribute__((address_space(3))) bf16x8*)(kp+512);
  kf[2]=*(const __attribute__((address_space(3))) bf16x8*)(kp+2048); kf[3]=*(const __attribute__((address_space(3))) bf16x8*)(kp+2560);
  kf[4]=*(const __attribute__((address_space(3))) bf16x8*)(kp+4096); kf[5]=*(const __attribute__((address_space(3))) bf16x8*)(kp+4608);
  kf[6]=*(const __attribute__((address_space(3))) bf16x8*)(kp+6144); kf[7]=*(const __attribute__((address_space(3))) bf16x8*)(kp+6656);
}
__device__ __forceinline__ void kload2(bf16x8*kf,lds_cptr kp,int j){ kf[2*j]=*(const __attribute__((address_space(3))) bf16x8*)(kp+j*2048); kf[2*j+1]=*(const __attribute__((address_space(3))) bf16x8*)(kp+j*2048+512); }
__device__ __forceinline__ s16x4 vtr(lds_cptr p){ return __builtin_bit_cast(s16x4,__builtin_amdgcn_ds_read_tr16_b64_v4i16((__attribute__((address_space(3))) v4i16_t*)p)); }
__device__ __forceinline__ float rowmax(const f32x16&p0,const f32x16&p1){
  float a=max3f(p0[0],p0[1],p1[0]),b=max3f(p0[2],p0[3],p1[1]);a=max3f(a,p1[2],p1[3]);
  #pragma unroll
  for(int r=4;r<16;r+=4){a=max3f(a,p0[r],p0[r+1]);b=max3f(b,p0[r+2],p0[r+3]);a=max3f(a,p1[r],p1[r+1]);b=max3f(b,p1[r+2],p1[r+3]);}
  const float m=max2f(a,b);
  auto rr=__builtin_amdgcn_permlane32_swap(__float_as_uint(m),__float_as_uint(m),false,false);
  return max2f(__uint_as_float(rr[0]),__uint_as_float(rr[1]));
}
__device__ __forceinline__ void pv(f32x16*o,int vb,bf16x8 pa0,bf16x8 pa1,bf16x8 pa2,bf16x8 pa3){
  #pragma unroll
  for(int d0=0;d0<2;++d0){s16x4 lo[4],hi[4];
    #pragma unroll
    for(int ks=0;ks<4;++ks){
      asm volatile("ds_read_b64_tr_b16 %0,%1 offset:%c2":"=&v"(lo[ks]):"v"(vb),"i"(d0*4096+ks*1024):"memory");
      asm volatile("ds_read_b64_tr_b16 %0,%1 offset:%c2":"=&v"(hi[ks]):"v"(vb),"i"(d0*4096+ks*1024+512):"memory");}
    asm volatile("s_waitcnt lgkmcnt(0)":::"memory");SBAR();
    #define PK(k) (bf16x8){lo[k][0],lo[k][1],lo[k][2],lo[k][3],hi[k][0],hi[k][1],hi[k][2],hi[k][3]}
    o[d0]=__builtin_amdgcn_mfma_f32_32x32x16_bf16(pa0,PK(0),o[d0],0,0,0);
    o[d0]=__builtin_amdgcn_mfma_f32_32x32x16_bf16(pa1,PK(1),o[d0],0,0,0);
    o[d0]=__builtin_amdgcn_mfma_f32_32x32x16_bf16(pa2,PK(2),o[d0],0,0,0);
    o[d0]=__builtin_amdgcn_mfma_f32_32x32x16_bf16(pa3,PK(3),o[d0],0,0,0);
    #undef PK
  }
}
#ifndef ATTN_STORE16
#define ATTN_STORE16(p,v) (*(u32x4*)(p)=(v))
#endif
typedef __attribute__((address_space(3))) const float* lds_fptr;
struct AttnAux { const unsigned* list; float* ml; const unsigned* ent; const bf16* part; const float* mlr; float sl2; int nvalid; int base_off; int pad; };
template<int MODE,int THRL,bool RES=false,bool ST=false> __device__ __forceinline__ void attn_unit(const bf16*Qw0,int QP,const bf16*__restrict__ Kh,const bf16*__restrict__ Vh,int KVP,bf16*Ow0,int OP,int NTF,int T0,char*shm,const AttnAux&aux=AttnAux{},float m0=0.f){
  int tid_=threadIdx.x; asm volatile("":"+v"(tid_));
  const int tid=tid_,lane=tid&63,r32=lane&31,hi=lane>>5; const int wid=__builtin_amdgcn_readfirstlane(tid>>6);
  const bf16*Qw=Qw0+(long)(wid*QBLK)*QP;
  const int NT=NTF-T0;
  constexpr int NSL=RES?4:NSLOT, L_K=0, L_V=NSL*SLOTB, L_WS=RES?65536:LDS_WS, L_OST=RES?67584:LDS_OST, L_GT=RES?RES_GT_OFF:GT_OFF;
  const unsigned lds0=(unsigned)(uintptr_t)shm;
  float*wsf=(float*)(shm+L_WS)+wid*64;
  const bf16*ksrc=Kh+(long)lane*KVP+wid*8;
  const bf16*vsrc=Vh+(long)(16*(wid&3)+(lane>>2))*KVP+(wid>>2)*32+(lane&3)*8;
  const unsigned kdst=lds0+L_K+wid*1024, vdst=lds0+L_V+wid*1024;
  #define TILE(s) (RES ? (s) : MODE==1 ? ((s)==0 ? NTF-4 : ((s)<=NT-4 ? T0+(s)-1 : T0+(s))) : T0+(s))
  #define BANDJ(s) ((MODE==0||MODE==4) ? (s)-(NT-4) : (MODE==1 ? ((s)==0 ? 0 : ((s)>NT-4 ? (s)-(NT-4) : -1)) : -1))
  #define DMA_K(t,slot) do{ if(!RES) glds16(ksrc+(long)TILE(t)*KVBLK*KVP,(unsigned)__builtin_amdgcn_readfirstlane(kdst+(slot))); }while(0)
  #define DMA_V(t,slot) do{ if(!RES) glds16(vsrc+(long)TILE(t)*KVBLK*KVP,(unsigned)__builtin_amdgcn_readfirstlane(vdst+(slot))); }while(0)
  #define WB(N) do{ if(RES){ asm volatile("s_waitcnt lgkmcnt(0)":::"memory"); } else { WAIT_BAR(N); } }while(0)
  const int vb0=(int)(lds0+L_V)+((lane>>4)&1)*32+(lane&3)*8+(4*hi+((lane&15)>>2))*64;
  const char*Kbase=shm+L_K; bf16x8 kf[8];
  const lds_cptr shm3=(lds_cptr)shm; const lds_cptr kp0=shm3+L_K+hi*1024+r32*16; const lds_cptr vp0=shm3+L_V+((lane>>4)&1)*32+(lane&3)*8+(4*hi+((lane&15)>>2))*64;
  const lds_fptr gp0=(lds_fptr)(shm3+L_GT)+4*hi;
  DMA_K(0,0);DMA_V(0,0);DMA_K(1,SLOTB);
  bf16x8 qr[4];
  u32x4 enp[4]; if constexpr(MODE==4){ _Pragma("unroll") for(int i=0;i<4;++i) enp[i]=*(const u32x4*)(aux.ent+(size_t)(wid*QBLK+i*8+(lane>>3))*4); }
  int tq=0;
  if(MODE==3){ const int e_=RES?r32:wid*QBLK+r32; tq=(int)aux.list[e_<aux.nvalid?e_:0]; }
  { const bf16*qrow=(MODE==3)?(Qw0+(long)tq*QP):(Qw+(long)r32*QP);
  #pragma unroll
  for(int d0=0;d0<4;++d0)qr[d0]=*reinterpret_cast<const bf16x8*>(&qrow[d0*16+hi*8]); }
  float mhat=ST?m0:0.f,l_reg=0.f;f32x16 o[2];o[0]=f32x16{};o[1]=f32x16{};
  const int qrel=wid*QBLK+r32;
  float gt=0.f; unsigned selbits=0xffffffffu;
  if(MODE==3) gt=-aux.sl2*(float)tq; else if(MODE!=2) gt=((lds_fptr)(shm3+L_GT))[64*(NTF-4)+qrel];
  if(MODE==1) selbits=((const __attribute__((address_space(3))) unsigned*)(shm3+SEL_OFF))[qrel];
  #define CI_LOAD(X0,X1,stp) do{ if(MODE!=2){ const lds_fptr gp_=gp0+64*TILE(stp); \
      _Pragma("unroll") for(int g_=0;g_<4;++g_){ const f32x4 a_=*(const __attribute__((address_space(3))) f32x4*)(gp_+8*g_); const f32x4 b_=*(const __attribute__((address_space(3))) f32x4*)(gp_+32+8*g_); \
        X0[4*g_]=a_[0];X0[4*g_+1]=a_[1];X0[4*g_+2]=a_[2];X0[4*g_+3]=a_[3]; X1[4*g_]=b_[0];X1[4*g_+1]=b_[1];X1[4*g_+2]=b_[2];X1[4*g_+3]=b_[3]; } } }while(0)
  #define CI_LOAD0(X0,stp) do{ if(MODE!=2){ const lds_fptr gp_=gp0+64*TILE(stp); \
      _Pragma("unroll") for(int g_=0;g_<4;++g_){ const f32x4 a_=*(const __attribute__((address_space(3))) f32x4*)(gp_+8*g_); X0[4*g_]=a_[0];X0[4*g_+1]=a_[1];X0[4*g_+2]=a_[2];X0[4*g_+3]=a_[3]; } } }while(0)
  #define CI_LOAD1(X1,stp) do{ if(MODE!=2){ const lds_fptr gp_=gp0+64*TILE(stp); \
      _Pragma("unroll") for(int g_=0;g_<4;++g_){ const f32x4 b_=*(const __attribute__((address_space(3))) f32x4*)(gp_+32+8*g_); X1[4*g_]=b_[0];X1[4*g_+1]=b_[1];X1[4*g_+2]=b_[2];X1[4*g_+3]=b_[3]; } } }while(0)
  #define CB(stp) ((MODE==1 && !((selbits>>(TILE(stp)>>2))&1u)) ? -INFINITY : (gt-mhat))
  #define CI_SUB4(X,B,cb) do{ if(MODE!=2){ X[B]=fsub_s((cb),X[B]); X[B+1]=fsub_s((cb),X[B+1]); X[B+2]=fsub_s((cb),X[B+2]); X[B+3]=fsub_s((cb),X[B+3]); }     else { X[B]=(cb); X[B+1]=(cb); X[B+2]=(cb); X[B+3]=(cb); } }while(0)
  #define CMASK(P0,P1,t) do{int jb_=BANDJ(t); if(jb_>=0)cmask(P0,P1,jb_,qrel,hi);}while(0)
  bool resc=false;
  #define START(P0,P1) do{ resc=false; \
    if constexpr(!ST){ const float rm=rowmax(P0,P1); const float dl=rm; mhat=fadd_s(mhat,dl); \
      _Pragma("unroll") for(int r=0;r<16;++r){P0[r]=fsub_s(P0[r],dl);P1[r]=fsub_s(P1[r],dl);} } \
    _Pragma("unroll") for(int r=0;r<16;++r)P0[r]=__builtin_amdgcn_exp2f(P0[r]); }while(0)
  #define RESC() do{ if(resc){ asm volatile("s_waitcnt lgkmcnt(0)":::"memory"); \
      _Pragma("unroll") for(int d_=0;d_<2;++d_) _Pragma("unroll") for(int r=0;r<16;++r)o[d_][r]*=wsf[crow(r,hi)]; } }while(0)
  f32x16 pA0,pA1,pB0,pB1;
  int sl_prev=0,sl_cur=0,sl_next=SLOTB;
  #define ROT() do{sl_prev=sl_cur;sl_cur=sl_next;sl_next=(sl_next==(NSL-1)*SLOTB)?0:sl_next+SLOTB;}while(0)
  DMA_K(2,2*SLOTB);
  { CI_LOAD(pA0,pA1,0); const float cb0=CB(0);
    CI_SUB4(pA0,0,cb0);CI_SUB4(pA0,4,cb0);CI_SUB4(pA0,8,cb0);CI_SUB4(pA0,12,cb0);CI_SUB4(pA1,0,cb0);CI_SUB4(pA1,4,cb0);CI_SUB4(pA1,8,cb0);CI_SUB4(pA1,12,cb0); }
  WB(3);
  qkt(pA0,pA1,Kbase,qr,r32,hi);asm volatile("s_nop 15\n\ts_nop 7":"+v"(pA0),"+v"(pA1));CMASK(pA0,pA1,0);
  START(pA0,pA1);
  _Pragma("unroll") for(int r=0;r<16;++r)pA1[r]=__builtin_amdgcn_exp2f(pA1[r]);
  { CI_LOAD(pB0,pB1,1); const float cb1=CB(1);
    CI_SUB4(pB0,0,cb1);CI_SUB4(pB0,4,cb1);CI_SUB4(pB0,8,cb1);CI_SUB4(pB0,12,cb1);CI_SUB4(pB1,0,cb1);CI_SUB4(pB1,4,cb1);CI_SUB4(pB1,8,cb1);CI_SUB4(pB1,12,cb1); }
  WB(0);
  DMA_K(3,0);DMA_V(1,SLOTB);
  ROT();
  kload8(kf,kp0+sl_cur);
  WB(2);
  s16x4 vlo[8],vhi[8]; u32x4 pw0,pw1,pw2,pw3;
  #define PKW(P,B) cvtpk_s(P[B],P[B+1])
  #define PAF(k) __builtin_bit_cast(bf16x8,pw##k)
  #define VFR(i) (bf16x8){vlo[i][0],vlo[i][1],vlo[i][2],vlo[i][3],vhi[i][0],vhi[i][1],vhi[i][2],vhi[i][3]}
  #define PIN(x) asm volatile("":"+v"(x))
  #define MX3(a,b,c) __builtin_fmaxf(__builtin_fmaxf((a),(b)),(c))
  #define GAPA(MF,CX,A0,A1,A2,A3,W0,W1,PW) do{ MF; sacc+=A0; sacb+=A1; sacc+=A2; sacb+=A3; PIN(sacc); PIN(sacb); W0; W1; PIN(PW); PIN(CX); SBAR(); }while(0)
  #define EX(v) __builtin_amdgcn_exp2f(v)
  #define GAPB(MF,X,B,PN,PB,GN) do{ MF; X[B]=EX(X[B]); X[B+1]=EX(X[B+1]); X[B+2]=EX(X[B+2]); X[B+3]=EX(X[B+3]); PIN(X); if(GN){ CI_SUB4(PN,PB,cbn); PIN(PN); } SBAR(); }while(0)
  #define VRD(i) do{ vlo[i]=vtr(vp_+(((i)>>2)*4096+((i)&3)*1024)); vhi[i]=vtr(vp_+(((i)>>2)*4096+((i)&3)*1024+512)); }while(0)
  #define KRD(G,j) do{ if(G){ kload2(kf,kp0+sl_next,j); SBAR(); } }while(0)
  #define STEP(C0,C1,P0,P1,t,GK,GV,GL,GN) do{ SBAR(); \
    const lds_cptr vp_=vp0+sl_prev; \
    VRD(0); SBAR(); float sacc=P0[0],sacb=P0[1]; \
    GAPA(C0=__builtin_amdgcn_mfma_f32_32x32x16_bf16(kf[0],qr[0],C0,0,0,0), C0, P0[2],P0[3],P0[4],P0[5],     pw0[0]=PKW(P0,0), pw0[1]=PKW(P0,2), pw0); \
    VRD(4); SBAR(); GAPA(C1=__builtin_amdgcn_mfma_f32_32x32x16_bf16(kf[1],qr[0],C1,0,0,0), C1, P0[6],P0[7],P0[8],P0[9],     pw0[2]=PKW(P0,4), pw0[3]=PKW(P0,6), pw0); \
    VRD(1); SBAR(); GAPA(C0=__builtin_amdgcn_mfma_f32_32x32x16_bf16(kf[2],qr[1],C0,0,0,0), C0,   P0[10],P0[11],P0[12],P0[13], pw1[0]=PKW(P0,8), pw1[1]=PKW(P0,10), pw1); \
    VRD(5); SBAR(); GAPA(C1=__builtin_amdgcn_mfma_f32_32x32x16_bf16(kf[3],qr[1],C1,0,0,0), C1,   P0[14],P0[15],P1[0],P1[1],   pw1[2]=PKW(P0,12),pw1[3]=PKW(P0,14), pw1); \
    if(GN){ CI_LOAD0(P0,(t)+1); SBAR(); }     \
    VRD(2); SBAR(); GAPA(C0=__builtin_amdgcn_mfma_f32_32x32x16_bf16(kf[4],qr[2],C0,0,0,0), C0,   P1[2],P1[3],P1[4],P1[5],     pw2[0]=PKW(P1,0), pw2[1]=PKW(P1,2), pw2); \
    VRD(6); SBAR(); GAPA(C1=__builtin_amdgcn_mfma_f32_32x32x16_bf16(kf[5],qr[2],C1,0,0,0), C1,   P1[6],P1[7],P1[8],P1[9],     pw2[2]=PKW(P1,4), pw2[3]=PKW(P1,6), pw2); \
    VRD(3); SBAR(); GAPA(C0=__builtin_amdgcn_mfma_f32_32x32x16_bf16(kf[6],qr[3],C0,0,0,0), C0,   P1[10],P1[11],P1[12],P1[13], pw3[0]=PKW(P1,8), pw3[1]=PKW(P1,10), pw3); \
    VRD(7); SBAR(); GAPA(C1=__builtin_amdgcn_mfma_f32_32x32x16_bf16(kf[7],qr[3],C1,0,0,0), C1,   P1[14],P1[15],0.f,0.f,       pw3[2]=PKW(P1,12),pw3[3]=PKW(P1,14), pw3); \
    l_reg+=sacc+sacb; \
    if(GN){ CI_LOAD1(P1,(t)+1); } \
    CMASK(C0,C1,t); \
    if constexpr(!ST){ float a=MX3(C0[0],C0[1],C1[0]),b=MX3(C0[2],C0[3],C1[1]); a=MX3(a,C1[2],C1[3]); \
      _Pragma("unroll") for(int r=4;r<16;r+=4){a=MX3(a,C0[r],C0[r+1]);b=MX3(b,C0[r+2],C0[r+3]);a=MX3(a,C1[r],C1[r+1]);b=MX3(b,C1[r+2],C1[r+3]);} \
      float rm=__builtin_fmaxf(a,b); { auto rr=__builtin_amdgcn_permlane32_swap(__float_as_uint(rm),__float_as_uint(rm),false,false); rm=__builtin_fmaxf(__uint_as_float(rr[0]),__uint_as_float(rr[1])); } \
      resc=false; \
      if(__builtin_expect(__any(rm>(float)THRL),0)){ const float dl=(rm>(float)THRL)?rm:0.f; mhat+=dl;     \
        _Pragma("unroll") for(int r=0;r<16;++r){C0[r]-=dl;C1[r]-=dl;} \
        const float f=__builtin_amdgcn_exp2f(-dl); l_reg*=f; if(hi==0)wsf[r32]=f; resc=true; } } \
    float cbn=0.f; if(GN){ cbn=CB((t)+1); } \
    SBAR(); \
    GAPB(o[0]=__builtin_amdgcn_mfma_f32_32x32x16_bf16(PAF(0),VFR(0),o[0],0,0,0), C0,0, P0,0,GN); \
    GAPB(o[1]=__builtin_amdgcn_mfma_f32_32x32x16_bf16(PAF(0),VFR(4),o[1],0,0,0), C0,4, P0,4,GN); \
    if(GK){DMA_K((t)+3,sl_cur); SBAR();}     \
    KRD(GL,0); GAPB(o[0]=__builtin_amdgcn_mfma_f32_32x32x16_bf16(PAF(1),VFR(1),o[0],0,0,0), C0,8, P0,8,GN); \
    KRD(GL,1); GAPB(o[1]=__builtin_amdgcn_mfma_f32_32x32x16_bf16(PAF(1),VFR(5),o[1],0,0,0), C0,12, P0,12,GN); \
    KRD(GL,2); GAPB(o[0]=__builtin_amdgcn_mfma_f32_32x32x16_bf16(PAF(2),VFR(2),o[0],0,0,0), C1,0, P1,0,GN); \
    KRD(GL,3); GAPB(o[1]=__builtin_amdgcn_mfma_f32_32x32x16_bf16(PAF(2),VFR(6),o[1],0,0,0), C1,4, P1,4,GN); \
    if(GV){DMA_V((t)+1,sl_next); SBAR();} \
    GAPB(o[0]=__builtin_amdgcn_mfma_f32_32x32x16_bf16(PAF(3),VFR(3),o[0],0,0,0), C1,8, P1,8,GN); \
    GAPB(o[1]=__builtin_amdgcn_mfma_f32_32x32x16_bf16(PAF(3),VFR(7),o[1],0,0,0), C1,12, P1,12,GN); \
    }while(0)
  int t=1;
  #undef CMASK
  #define CMASK(P0,P1,t) do{}while(0)
  for(;t+5<NT;t+=2){
    STEP(pB0,pB1,pA0,pA1,t,true,true,true,true);     WB(2); RESC(); ROT();
    STEP(pA0,pA1,pB0,pB1,t+1,true,true,true,true);   WB(2); RESC(); ROT();
  }
  #undef CMASK
  #define CMASK(P0,P1,t) do{int jb_=BANDJ(t); if(jb_>=0)cmask(P0,P1,jb_,qrel,hi);}while(0)
  #define ENDW(tt) do{ if((tt)+3<NT){WB(2);} else if((tt)+2<NT){WB(1);} else {WB(0);} }while(0)
  #define TAIL(P0,P1,VS) do{ float sacc=P0[0]+P0[1]; _Pragma("unroll") for(int r=2;r<16;++r)sacc+=P0[r]; _Pragma("unroll") for(int r=0;r<16;++r)sacc+=P1[r]; l_reg+=sacc; \
    pw0=(u32x4){PKW(P0,0),PKW(P0,2),PKW(P0,4),PKW(P0,6)};pw1=(u32x4){PKW(P0,8),PKW(P0,10),PKW(P0,12),PKW(P0,14)};pw2=(u32x4){PKW(P1,0),PKW(P1,2),PKW(P1,4),PKW(P1,6)};pw3=(u32x4){PKW(P1,8),PKW(P1,10),PKW(P1,12),PKW(P1,14)}; \
    SBAR(); pv(o,vb0+(VS),PAF(0),PAF(1),PAF(2),PAF(3)); }while(0)
  if constexpr(MODE==4&&RES){
    const int ntw=(wid>>1)+1;
    if(ntw>1){ STEP(pB0,pB1,pA0,pA1,1,false,true,true,true); WB(1); RESC(); }
    if(ntw>2){ ROT(); STEP(pA0,pA1,pB0,pB1,2,false,true,true,true); WB(0); RESC(); }
    if(ntw>3){ ROT(); STEP(pB0,pB1,pA0,pA1,3,false,false,false,false); RESC(); }
    if(ntw&1){ pB0=pA0; pB1=pA1; }
    const int vs_=(ntw==1)?sl_prev:sl_cur;
    TAIL(pB0,pB1,vs_);
  } else if constexpr(MODE==0){
  #define LIGHT(tt,GK,GV) do{ resc=false; if(GK){DMA_K((tt)+3,sl_cur);} if(GV){DMA_V((tt)+1,sl_next);} }while(0)
  if(t+3<NT){
    STEP(pB0,pB1,pA0,pA1,t,true,true,true,true);      WB(2); RESC(); ROT();
    STEP(pA0,pA1,pB0,pB1,t+1,true,true,true,true);    WB(2); RESC(); ROT();
    t+=2; }
  STEP(pB0,pB1,pA0,pA1,t,false,true,true,true);       WB(1); RESC(); ROT();
  if(wid>=2){ STEP(pA0,pA1,pB0,pB1,t+1,false,true,true,true); } else { LIGHT(t+1,false,true); }
  WB(0); RESC(); ROT();
  if(wid>=4){ STEP(pB0,pB1,pA0,pA1,t+2,false,false,false,false); RESC(); }
  if(wid>=6){ TAIL(pB0,pB1,sl_cur); }
  #undef LIGHT
  } else {
  for(;t+1<NT;t+=2){
    STEP(pB0,pB1,pA0,pA1,t,(t+3<NT),(t+1<NT),(t+1<NT),(t+1<NT));       ENDW(t);   RESC(); ROT();
    STEP(pA0,pA1,pB0,pB1,t+1,(t+4<NT),(t+2<NT),(t+2<NT),(t+2<NT));     ENDW(t+1); RESC(); ROT();
  }
  STEP(pB0,pB1,pA0,pA1,NT-1,false,false,false,false); RESC();
  TAIL(pB0,pB1,sl_cur);
  }
  #undef TAIL
  #undef PKW
  #undef PAF
  #undef VFR
  #undef PIN
  #undef MX3
  #undef GAPA
  #undef GAPB
  #undef EX
  #undef VRD
  #undef KRD
  #undef STEP
  #undef ENDW
  {auto rr=__builtin_amdgcn_permlane32_swap(__float_as_uint(l_reg),__float_as_uint(l_reg),false,false);l_reg=__uint_as_float(rr[0])+__uint_as_float(rr[1]);}
  if(hi==0){wsf[32+r32]=l_reg; if(MODE==4)wsf[r32]=mhat;} asm volatile("s_waitcnt lgkmcnt(0)":::"memory");
  float rli[16];
  #pragma unroll
  for(int r=0;r<16;++r){ const float lv_=wsf[32+crow(r,hi)]; rli[r]=(ST&&MODE==3&&!(lv_>0.f))?0.f:__builtin_amdgcn_rcpf(lv_); }
  bf16*Ow=(RES&&MODE==3)?Ow0:Ow0+(long)(wid*QBLK)*OP;
  if(MODE==3){ const int e_=RES?r32:wid*QBLK+r32; if(hi==0&&e_<aux.nvalid){ f32x2_t v_={mhat,l_reg}; *(f32x2_t*)(aux.ml+2*e_)=v_; } }
  { bf16*stg=(bf16*)(shm+L_OST)+wid*2048;
    #pragma unroll
    for(int r=0;r<16;++r){const int orow=crow(r,hi);
      #pragma unroll
      for(int d0=0;d0<2;++d0)stg[orow*64+d0*32+r32]=(bf16)(cvtpk_s(o[d0][r]*rli[r],0.f)&0xffffu);}
    asm volatile("s_waitcnt lgkmcnt(0)":::"memory");
    if(MODE==4){
      const lds_fptr basej=(lds_fptr)(shm3+aux.base_off);
      #pragma unroll
      for(int i=0;i<4;++i){const int row=i*8+(lane>>3),ch=lane&7; const u32x4 v=*(const u32x4*)(stg+row*64+ch*8);
        const float m0=wsf[row], l0=wsf[32+row];
        const u32x4 en=enp[i];
        float mk[3],lk[3]; u32x4 pk[3]; float M=m0;
        #pragma unroll
        for(int k=0;k<3;++k){ mk[k]=-INFINITY; lk[k]=0.f; pk[k]=(u32x4){0u,0u,0u,0u};
          if((unsigned)k<en[3]){ const unsigned e_=__float_as_uint(basej[en[k]>>16])+(en[k]&0xffffu); const f32x2_t ml_=*(const f32x2_t*)(aux.mlr+2*(size_t)e_); mk[k]=ml_[0]; lk[k]=ml_[1];
            pk[k]=*(const u32x4*)(aux.part+(size_t)e_*64+ch*8); M=fmaxf(M,mk[k]); } }
        const float w0=l0*__builtin_amdgcn_exp2f(m0-M); float wk[3],den=w0;
        #pragma unroll
        for(int k=0;k<3;++k){ wk[k]=lk[k]*__builtin_amdgcn_exp2f(mk[k]-M); den+=wk[k]; }
        const float rd=__builtin_amdgcn_rcpf(den); u32x4 ov;
        #pragma unroll
        for(int c=0;c<4;++c){ float a0=w0*__uint_as_float(v[c]<<16), a1=w0*__uint_as_float(v[c]&0xffff0000u);
          #pragma unroll
          for(int k=0;k<3;++k){ a0+=wk[k]*__uint_as_float(pk[k][c]<<16); a1+=wk[k]*__uint_as_float(pk[k][c]&0xffff0000u); }
          ov[c]=cvtpk_s(a0*rd,a1*rd); }
        ATTN_STORE16(Ow+(long)row*OP+ch*8,ov);}
    } else {
    #pragma unroll
    for(int i=0;i<4;++i){const int row=i*8+(lane>>3),ch=lane&7; const u32x4 v=*(const u32x4*)(stg+row*64+ch*8); if(MODE!=3||(RES?row:wid*QBLK+row)<aux.nvalid) ATTN_STORE16(Ow+(long)row*OP+ch*8,v);} } }
  if(RES) asm volatile("s_waitcnt lgkmcnt(0)":::"memory"); else asm volatile("s_waitcnt lgkmcnt(0)\n\ts_barrier":::"memory");
  #undef WB
  #undef DMA_K
  #undef DMA_V
  #undef CMASK
  #undef START
  #undef RESC
  #undef ROT
  #undef TILE
  #undef BANDJ
  #undef CI_LOAD
  #undef CI_LOAD0
  #undef CI_LOAD1
  #undef CB
  #undef CI_SUB4
}
constexpr int ATTN_LDS_BYTES=LDS_BYTES;

__device__ __forceinline__ int tile_start(const char*shm,int NTF,float thr){
  int tid_=threadIdx.x; asm volatile("":"+v"(tid_)); const int lane=tid_&63; const lds_fptr gt=(lds_fptr)((lds_cptr)shm+GT_OFF);
  const float g0=gt[64*(NTF-4)];
  const int t1=lane, t2=lane+64;
  const bool ok1=(t1<NTF)&&(g0-gt[64*(t1<NTF?t1:0)+63]>=-thr), ok2=(t2<NTF)&&(g0-gt[64*(t2<NTF?t2:0)+63]>=-thr);
  const unsigned long long m1=__ballot(ok1), m2=__ballot(ok2);
  int ts = m1 ? (int)__builtin_ctzll(m1) : (m2 ? 64+(int)__builtin_ctzll(m2) : NTF-4);
  ts&=~1; if(ts>NTF-4)ts=NTF-4;
  return __builtin_amdgcn_readfirstlane(ts);
}
__device__ __forceinline__ float skip_thr(float maxq2,float maxk2){ return 150.0f+2.0f*(1.02f*sqrtf(maxq2*maxk2)+1.0f); }
__device__ __forceinline__ float skip_eff(float thr){ return thr<210.0f ? 128.0f : thr; }
typedef __attribute__((address_space(3))) float* lds_fwptr;
__device__ __forceinline__ float thr_from_nmax(const float*nm){ const f32x4 v=*(const f32x4*)nm; return skip_thr(v[0]+v[1],v[2]+v[3]); }
__device__ __forceinline__ void build_gtab_fox(const float*LFrow,char*shm){
  int tid_=threadIdx.x; asm volatile("":"+v"(tid_)); const int tid=tid_,lane=tid&63,wid=tid>>6;
  lds_fwptr gt=(lds_fwptr)(shm+GT_OFF); lds_fwptr red=(lds_fwptr)(shm+RED_OFF);
  float v[16];
  #pragma unroll
  for(int j=0;j<4;++j){const f32x4 x=*(const f32x4*)(LFrow+tid*16+4*j); v[4*j]=x[0];v[4*j+1]=x[1];v[4*j+2]=x[2];v[4*j+3]=x[3];}
  #pragma unroll
  for(int j=1;j<16;++j)v[j]+=v[j-1];
  const float tot=v[15]; float inc=tot;
  #pragma unroll
  for(int o=1;o<64;o<<=1){const float n=__shfl_up(inc,o); if(lane>=o)inc+=n;}
  if(lane==63)red[wid]=inc;
  __syncthreads();
  float woff=0.f;
  #pragma unroll
  for(int w=0;w<8;++w){ const float x=red[w]; if(w<wid)woff+=x; }
  const float off=woff+(inc-tot);
  #pragma unroll
  for(int j=0;j<4;++j){ f32x4 x; x[0]=v[4*j]+off;x[1]=v[4*j+1]+off;x[2]=v[4*j+2]+off;x[3]=v[4*j+3]+off; *(__attribute__((address_space(3))) f32x4*)(gt+tid*16+4*j)=x; }
  __syncthreads();
}
__device__ __forceinline__ void build_tabs_moba(float sl2,const float*kmean_bh  ,char*shm){
  int tid_=threadIdx.x; asm volatile("":"+v"(tid_)); const int tid=tid_;
  lds_fwptr gt=(lds_fwptr)(shm+GT_OFF); lds_fwptr km=(lds_fwptr)(shm+KM_OFF);
  #pragma unroll
  for(int j=0;j<4;++j){ f32x4 x; const int s=tid*16+4*j; x[0]=-sl2*(float)s;x[1]=-sl2*(float)(s+1);x[2]=-sl2*(float)(s+2);x[3]=-sl2*(float)(s+3); *(__attribute__((address_space(3))) f32x4*)(gt+s)=x; }
  { const int blk=tid>>4, c=(tid&15)*4; const f32x4 x=*(const f32x4*)(kmean_bh+(size_t)blk*768+c); *(__attribute__((address_space(3))) f32x4*)(km+blk*64+c)=x; }
  __syncthreads();
}
__device__ __forceinline__ void moba_route(const bf16*Qw0,int QP,int qb,char*shm){
  int tid_=threadIdx.x; asm volatile("":"+v"(tid_)); const int tid=tid_,row=tid>>1,half=tid&1;
  const lds_fptr km=(lds_fptr)(shm+KM_OFF)+half*32;
  float q[32];
  #pragma unroll
  for(int j=0;j<4;++j){ const u32x4 x=*(const u32x4*)(Qw0+(long)row*QP+half*32+8*j);
    #pragma unroll
    for(int k=0;k<4;++k){ q[8*j+2*k]=__uint_as_float(x[k]<<16); q[8*j+2*k+1]=__uint_as_float(x[k]&0xffff0000u); } }
  float g0=-INFINITY,g1=-INFINITY,g2=-INFINITY; int i0=-1,i1=-1,i2=-1;
  for(int n=0;n<qb;++n){
    float d=0.f;
    #pragma unroll
    for(int j=0;j<8;++j){ const f32x4 k4=*(const __attribute__((address_space(3))) f32x4*)(km+n*64+4*j); d+=q[4*j]*k4[0]; d+=q[4*j+1]*k4[1]; d+=q[4*j+2]*k4[2]; d+=q[4*j+3]*k4[3]; }
    d+=__shfl_xor(d,1);
    if(d>g0){g2=g1;i2=i1;g1=g0;i1=i0;g0=d;i0=n;} else if(d>g1){g2=g1;i2=i1;g1=d;i1=n;} else if(d>g2){g2=d;i2=n;}
  }
  unsigned bits=1u<<qb; if(i0>=0)bits|=1u<<i0; if(i1>=0)bits|=1u<<i1; if(i2>=0)bits|=1u<<i2;
  if(half==0)((__attribute__((address_space(3))) unsigned*)(shm+SEL_OFF))[row]=bits;
  __syncthreads();
}
__device__ __forceinline__ void load_block_kv(const bf16*Kh,const bf16*Vh,int KVP,int blk,float sl2,char*shm){
  int tid_=threadIdx.x; asm volatile("":"+v"(tid_)); const int tid=tid_,lane=tid&63; const int wid=__builtin_amdgcn_readfirstlane(tid>>6);
  const unsigned lds0=(unsigned)(uintptr_t)shm;
  const bf16*ksrc=Kh+(long)(256*blk+lane)*KVP+wid*8;
  const bf16*vsrc=Vh+(long)(256*blk+16*(wid&3)+(lane>>2))*KVP+(wid>>2)*32+(lane&3)*8;
  #pragma unroll
  for(int tl=0;tl<4;++tl){ glds16(ksrc+(long)tl*KVBLK*KVP,(unsigned)__builtin_amdgcn_readfirstlane(lds0+tl*SLOTB+wid*1024)); glds16(vsrc+(long)tl*KVBLK*KVP,(unsigned)__builtin_amdgcn_readfirstlane(lds0+4*SLOTB+tl*SLOTB+wid*1024)); }
  if(tid<256)((__attribute__((address_space(3))) float*)(shm+RES_GT_OFF))[tid]=-sl2*(float)(256*blk+tid);
  asm volatile("s_waitcnt vmcnt(0) lgkmcnt(0)\n\ts_barrier":::"memory");
}
__device__ __forceinline__ bool gate_better(float g,int i,float cg,int ci){ return g>cg||(g==cg&&i<ci); }
#define T3_INSERT(g_,i_) do{ const float tg_=(g_); const int ti_=(i_); const bool b0_=gate_better(tg_,ti_,g0,i0), b1_=gate_better(tg_,ti_,g1,i1), b2_=gate_better(tg_,ti_,g2,i2); \
    const float n2_=b1_?g1:(b2_?tg_:g2); const int m2_=b1_?i1:(b2_?ti_:i2); const float n1_=b0_?g0:(b1_?tg_:g1); const int m1_=b0_?i0:(b1_?ti_:i1); \
    g0=b0_?tg_:g0; i0=b0_?ti_:i0; g1=n1_; i1=m1_; g2=n2_; i2=m2_; }while(0)
__device__ __forceinline__ void moba_route_lists(const bf16*Qw0,int QP,int qb,float sl2,float thr,unsigned*cnt,unsigned*list,unsigned*ent,const char*shm){
  int tid_=threadIdx.x; asm volatile("":"+v"(tid_)); const int tid=tid_,lane=tid&63,r32=lane&31,hi=lane>>5; const int wid=__builtin_amdgcn_readfirstlane(tid>>6);
  const lds_fptr km=(lds_fptr)((lds_cptr)shm+KM_OFF)+r32*64+8*hi;
  const bf16*Qw=Qw0+(long)(wid*QBLK+r32)*QP+hi*8;
  f32x16 gate=f32x16{};
  #pragma unroll
  for(int d0=0;d0<4;++d0){
    const bf16x8 qf=*reinterpret_cast<const bf16x8*>(Qw+d0*16);
    const f32x4 k0=*(const __attribute__((address_space(3))) f32x4*)(km+16*d0), k1=*(const __attribute__((address_space(3))) f32x4*)(km+16*d0+4);
    u32x4 ah,al;
    #pragma unroll
    for(int c=0;c<2;++c){ const f32x4 kv=c?k1:k0;
      const unsigned h01=cvtpk_s(kv[0],kv[1]), h23=cvtpk_s(kv[2],kv[3]);
      const float r0=kv[0]-__uint_as_float(h01<<16), r1=kv[1]-__uint_as_float(h01&0xffff0000u), r2=kv[2]-__uint_as_float(h23<<16), r3=kv[3]-__uint_as_float(h23&0xffff0000u);
      ah[2*c]=h01; ah[2*c+1]=h23; al[2*c]=cvtpk_s(r0,r1); al[2*c+1]=cvtpk_s(r2,r3); }
    gate=__builtin_amdgcn_mfma_f32_32x32x16_bf16(__builtin_bit_cast(bf16x8,ah),qf,gate,0,0,0);
    gate=__builtin_amdgcn_mfma_f32_32x32x16_bf16(__builtin_bit_cast(bf16x8,al),qf,gate,0,0,0);
  }
  float g0=-INFINITY,g1=-INFINITY,g2=-INFINITY; int i0=64,i1=64,i2=64;
  #pragma unroll
  for(int r=0;r<16;++r){ const int blk=crow(r,hi); const bool ok=blk<qb; T3_INSERT(ok?gate[r]:-INFINITY, ok?blk:64); }
  { const float p0=__shfl_xor(g0,32),p1=__shfl_xor(g1,32),p2=__shfl_xor(g2,32); const int j0=__shfl_xor(i0,32),j1=__shfl_xor(i1,32),j2=__shfl_xor(i2,32);
    T3_INSERT(p0,j0); T3_INSERT(p1,j1); T3_INSERT(p2,j2); }
  const int t=256*qb+wid*QBLK+r32; unsigned bits=0u;
  if(i0<64&&sl2*(float)(t-(256*i0+255))<=thr)bits|=1u<<i0;
  if(i1<64&&sl2*(float)(t-(256*i1+255))<=thr)bits|=1u<<i1;
  if(i2<64&&sl2*(float)(t-(256*i2+255))<=thr)bits|=1u<<i2;
  if(hi)bits=0u;
  unsigned mycnt=0u;
  for(int j=0;j<qb;++j){ const unsigned long long m=__ballot((bits>>j)&1u); if(lane==j)mycnt=(unsigned)__builtin_popcountll(m); }
  unsigned base=0u; if(lane<qb&&mycnt>0u)base=__hip_atomic_fetch_add(cnt+lane,mycnt,__ATOMIC_RELAXED,__HIP_MEMORY_SCOPE_AGENT);
  unsigned e0=0u,e1=0u,e2=0u,k=0u;
  for(int j=0;j<qb;++j){ const unsigned long long m=__ballot((bits>>j)&1u); const unsigned bj=(unsigned)__builtin_amdgcn_readlane((int)base,j);
    if((bits>>j)&1u){ const unsigned pos=bj+(unsigned)__builtin_popcountll(m&((1ull<<lane)-1ull)); list[(size_t)j*8192+pos]=(unsigned)t; const unsigned v=((unsigned)j<<16)|pos;
      if(k==0u)e0=v; else if(k==1u)e1=v; else e2=v; ++k; } }
  if(!hi){ const u32x4 en={e0,e1,e2,k}; *(u32x4*)(ent+(size_t)t*4)=en; }
}
#undef SBAR
#undef WAIT_BAR
}

constexpr int NWAVES = 8;
constexpr int RING_OFF = 0, RING_BYTES = 131072;
constexpr int LDSCTL_OFF = RING_BYTES, MISC_OFF = LDSCTL_OFF + 320;
constexpr int LDS_BYTES = 147456;
static_assert(attn_body::ATTN_LDS_END <= RING_BYTES, "attention LDS map");
constexpr int CW_TMO = 0, CW_BAR = 4096, CW_QUEUE = 8192;
constexpr int CW_NMAX = 24576;
constexpr int CW_CNT = 16384;
constexpr size_t OUT_LIST = 68 * MiB;
constexpr size_t WS_PARTB = 408 * MiB, WS_ML = 476 * MiB, WS_ENT = 485 * MiB, WS_END3 = 492 * MiB;
constexpr int PART_PER_BH = 23040;
constexpr size_t WS_QN = 404 * MiB, WS_KN = WS_QN + 1536 * 1024, WS_END2 = 407 * MiB;
constexpr size_t WL_STRIDE = 24 * MiB, WL_IN = 0, WL_OUT = 5632 * 1024, WL_GU = WL_OUT + 2 * MiB, WL_DN = WL_GU + 11 * MiB, W_MKV = 96 * MiB;
static_assert(WL_DN + (size_t)1024 * 2816 * 2 <= WL_STRIDE && WS_W + W_MKV + 4 * MiB <= WS_HB, "weight map");
constexpr int NPROJ_FOX = 2560, NPROJ_MOBA = 2560;
constexpr int N_PHASES = 30;

#define GAS __attribute__((address_space(1)))
#define LAS __attribute__((address_space(3)))
typedef unsigned v4u __attribute__((ext_vector_type(4)));
typedef float f32x4 __attribute__((ext_vector_type(4)));
typedef GAS unsigned gu32;
#define RLX_AGENT __ATOMIC_RELAXED, __HIP_MEMORY_SCOPE_AGENT
#define LDS_WAIT() asm volatile("s_waitcnt lgkmcnt(0)" ::: "memory")
#define VM_WAIT() asm volatile("s_waitcnt vmcnt(0)" ::: "memory")
__device__ __forceinline__ unsigned pk2(float lo, float hi) { return (unsigned)f2bf(lo) | ((unsigned)f2bf(hi) << 16); }

#define XB_TMO      128
#define XB_XCNT(j)  (256  + 64 * (j))
#define XB_XSUB(j)  (1280 + 64 * (j))
#define XB_XGEN(j)  (2304 + 64 * (j))
#define XB_TOP      3328
#define XB_TOPGEN   3392
#define XCD_BAR_WORDS 3456
#define XB_SPIN_CAP (1u << 18)

__device__ __forceinline__ unsigned xb_ld(unsigned* p)              { return __hip_atomic_load(p, __ATOMIC_RELAXED, __HIP_MEMORY_SCOPE_AGENT); }
__device__ __forceinline__ unsigned xb_add(unsigned* p, unsigned v) { return __hip_atomic_fetch_add(p, v, __ATOMIC_RELAXED, __HIP_MEMORY_SCOPE_AGENT); }
__device__ __forceinline__ unsigned xb_xcc_id() { return (unsigned)__builtin_amdgcn_s_getreg((3 << 11) | 20) & 0xFu; }
#define XB_SPIN(cond, bar) do { unsigned _sp = 0; while (cond) { __builtin_amdgcn_s_sleep(1); \
    if ((++_sp & 255u) == 0u) { if (xb_ld(&(bar)[XB_TMO])) break; if (_sp > XB_SPIN_CAP) { atomicAdd(&(bar)[XB_TMO], 1u); break; } } } } while (0)

struct XcdBarrier {
    unsigned* bar; unsigned x;
    volatile LAS unsigned* st;
};

__device__ __forceinline__ XcdBarrier xcd_barrier_post(unsigned* bar, volatile LAS unsigned* st) {
    XcdBarrier b; b.bar = bar; b.x = xb_xcc_id(); b.st = st;
    if (threadIdx.x == 0) (void)xb_add(&bar[XB_XCNT(b.x)], 1u);
    return b;
}
__device__ __forceinline__ void xcd_barrier_complete(unsigned* bar, unsigned x, unsigned& nloc, unsigned& nx) {
    const unsigned G = gridDim.x * gridDim.y * gridDim.z;
    unsigned sum, cnt, mine, sp = 0u;
    for (;;) {
        sum = 0u; cnt = 0u; mine = 0u;
#pragma unroll
        for (unsigned j = 0; j < 16; ++j) { const unsigned c = xb_ld(&bar[XB_XCNT(j)]); sum += c; cnt += (c > 0u) ? 1u : 0u; mine = (j == x) ? c : mine; }
        if (sum == G) break;
        __builtin_amdgcn_s_sleep(1);
        if ((++sp & 255u) == 0u) { if (xb_ld(&bar[XB_TMO])) break; if (sp > XB_SPIN_CAP) { atomicAdd(&bar[XB_TMO], 1u); break; } }
    }
    nloc = mine > 0u ? mine : 1u; nx = cnt > 0u ? cnt : 1u;
}

__device__ __forceinline__ void xcd_barrier(const XcdBarrier& b) {
    asm volatile("s_waitcnt vmcnt(0)" ::: "memory");
    __syncthreads();
    if (threadIdx.x == 0) {
        unsigned* bar = b.bar; asm volatile("" : "+s"(bar));
        __builtin_amdgcn_s_waitcnt(0);
        unsigned nloc = b.st[0], nx = b.st[1];
        if (nloc == 0u) { xcd_barrier_complete(bar, b.x, nloc, nx); b.st[0] = nloc; b.st[1] = nx; }
        const unsigned old = xb_add(&bar[XB_XSUB(b.x)], 1u);
        const unsigned gen = old / nloc;
        if (old + 1u == (gen + 1u) * nloc) {
            __builtin_amdgcn_fence(__ATOMIC_RELEASE, "agent");
            asm volatile("s_waitcnt vmcnt(0)" ::: "memory");
            const unsigned og = xb_add(&bar[XB_TOP], 1u);
            const unsigned tg = og / nx;
            if (og + 1u == (tg + 1u) * nx) xb_add(&bar[XB_TOPGEN], 1u);
            else XB_SPIN(xb_ld(&bar[XB_TOPGEN]) == tg, bar);
            __builtin_amdgcn_fence(__ATOMIC_ACQUIRE, "agent");
            xb_add(&bar[XB_XGEN(b.x)], 1u);
            asm volatile("s_waitcnt vmcnt(0)" ::: "memory");
        } else {
            XB_SPIN(xb_ld(&bar[XB_XGEN(b.x)]) == gen, bar);
            __builtin_amdgcn_fence(__ATOMIC_ACQUIRE, "agent");
            asm volatile("s_waitcnt vmcnt(0)" ::: "memory");
        }
    }
    __syncthreads();
}


struct Args { const float* in[13]; float* out; unsigned char* ws; int ph_lo, ph_hi, flags, pad; };

__device__ __forceinline__ void conv_item(const float* W, int Nsrc, const float* gain, bf16* WT, int K, int dst_row0, int src0, int nvalid, int k0, LAS float* scr, int lane) {
    float v[32]; const int j = lane & 31;
#pragma unroll
    for (int i = 0; i < 32; ++i) { const int kk = 2 * i + (lane >> 5); v[i] = (j < nvalid) ? W[(size_t)(k0 + kk) * Nsrc + src0 + j] : 0.f; }
    if (gain) {
#pragma unroll
        for (int i = 0; i < 32; ++i) v[i] *= gain[k0 + 2 * i + (lane >> 5)]; }
#pragma unroll
    for (int i = 0; i < 32; ++i) scr[(2 * i + (lane >> 5)) * 33 + j] = v[i];
    LDS_WAIT(); asm volatile("" ::: "memory");
    const int c = lane & 7;
#pragma unroll
    for (int j = 0; j < 4; ++j) { const int n = (lane >> 3) + 8 * j; const LAS float* s = scr + (8 * c) * 33 + n;
        v4u o; o.x = pk2(s[0 * 33], s[1 * 33]); o.y = pk2(s[2 * 33], s[3 * 33]); o.z = pk2(s[4 * 33], s[5 * 33]); o.w = pk2(s[6 * 33], s[7 * 33]);
        *(GAS v4u*)(WT + (size_t)(dst_row0 + n) * K + k0 + 8 * c) = o; }
    LDS_WAIT(); asm volatile("" ::: "memory");
}

__device__ __forceinline__ void flogit_job(const bf16* hb, const bf16* Wf, const float* ssq, const float* bfg, float* LF, int row0, int lane) {
    typedef short bf16x8v __attribute__((ext_vector_type(8)));
    const int r = lane & 15, kq = lane >> 4;
    const bf16x8v* ap = (const bf16x8v*)(Wf + (size_t)r * D + 8 * kq); const bf16x8v* bp = (const bf16x8v*)(hb + (size_t)(row0 + r) * D + 8 * kq);
    f32x4 acc0 = {0.f, 0.f, 0.f, 0.f}, acc1 = {0.f, 0.f, 0.f, 0.f};
#pragma unroll 8
    for (int kk = 0; kk < D / 32; kk += 2) {
        acc0 = __builtin_amdgcn_mfma_f32_16x16x32_bf16(ap[4 * kk], bp[4 * kk], acc0, 0, 0, 0);
        acc1 = __builtin_amdgcn_mfma_f32_16x16x32_bf16(ap[4 * kk + 4], bp[4 * kk + 4], acc1, 0, 0, 0); }
    const f32x4 p = *(const f32x4*)(ssq + (size_t)(row0 + r) * 16 + 4 * kq);
    float s = (p[0] + p[1]) + (p[2] + p[3]); s += __shfl_xor(s, 16); s += __shfl_xor(s, 32);
    const float rstd = rsqrtf(s * (1.0f / D) + RMS_EPS);
    const int row = row0 + r, b = row >> 13, t = row & 8191;
    if (kq < 3) {
#pragma unroll
        for (int i = 0; i < 4; ++i) { const int h = 4 * kq + i; const float z2 = ((acc0[i] + acc1[i]) * rstd + bfg[h]) * LOG2E;
            LF[((size_t)b * NSH + h) * T + t] = fminf(z2, 0.f) - __builtin_amdgcn_logf(1.0f + __builtin_amdgcn_exp2f(-fabsf(z2))); } }
}

struct ConvSrc { const float *w_in_fox, *w_in_moba, *norm_mix, *w_out, *w_gate_up, *norm_ffn, *w_down, *w_mem_kv, *norm_mem; };
constexpr int I_IN = 88 * 16, I_OUT = 32 * 16, I_GU = 176 * 16, I_DN = 32 * 44, I_L = I_IN + I_OUT + I_GU + I_DN, I_MKV = 64 * 16, NITEMS = 4 * I_L + I_MKV;
__device__ __forceinline__ void conv_dispatch(int it, const ConvSrc& cs, unsigned char* ws, LAS float* scr, int lane) {
    const float* w_in_fox = cs.w_in_fox; const float* w_in_moba = cs.w_in_moba; const float* norm_mix = cs.norm_mix; const float* w_out = cs.w_out; const float* w_gate_up = cs.w_gate_up;
    const float* norm_ffn = cs.norm_ffn; const float* w_down = cs.w_down; const float* w_mem_kv = cs.w_mem_kv; const float* norm_mem = cs.norm_mem;
    do {
            if (it < 4 * I_L) {
                const int L = it / I_L; int r = it % I_L; const int j = L >> 1; const bool fox = (L & 1) == 0;
                bf16* wl = (bf16*)(ws + WS_W + (size_t)L * WL_STRIDE);
                if (r < I_IN) { const int nb = r >> 4, kb = r & 15; int src0, nv = 32;
                    if (fox) { if (nb < 72) src0 = 32 * nb; else if (nb < 80) src0 = 2316 + 32 * (nb - 72); else if (nb == 80) { src0 = 2304; nv = 12; } else { src0 = 0; nv = 0; } }
                    else { if (nb < 80) src0 = 32 * nb; else { src0 = 0; nv = 0; } }
                    conv_item(fox ? w_in_fox + (size_t)j * D * FOXP : w_in_moba + (size_t)j * D * MOBAP, fox ? FOXP : MOBAP, norm_mix + (size_t)L * D, (bf16*)((unsigned char*)wl + WL_IN), D, 32 * nb, src0, nv, 64 * kb, scr, lane); break; }
                r -= I_IN;
                if (r < I_OUT) { const int nb = r >> 4, kb = r & 15; conv_item(w_out + (size_t)L * D * D, D, nullptr, (bf16*)((unsigned char*)wl + WL_OUT), D, 32 * nb, 32 * nb, 32, 64 * kb, scr, lane); break; }
                r -= I_OUT;
                if (r < I_GU) { const int nb = r >> 4, kb = r & 15, pn = nb >> 3, rb = nb & 7; const int src0 = (rb < 4) ? 128 * pn + 32 * rb : DFF + 128 * pn + 32 * (rb - 4);
                    conv_item(w_gate_up + (size_t)L * D * 2 * DFF, 2 * DFF, norm_ffn + (size_t)L * D, (bf16*)((unsigned char*)wl + WL_GU), D, 32 * nb, src0, 32, 64 * kb, scr, lane); break; }
                r -= I_GU;
                { const int nb = r / 44, kb = r % 44; conv_item(w_down + (size_t)L * DFF * D, D, nullptr, (bf16*)((unsigned char*)wl + WL_DN), DFF, 32 * nb, 32 * nb, 32, 64 * kb, scr, lane); }
            } else {
                const int r = it - 4 * I_L, nb = r >> 4, kb = r & 15, L = nb >> 4;
                conv_item(w_mem_kv + (size_t)L * D * 512, 512, norm_mem + (size_t)L * D, (bf16*)(ws + WS_W + W_MKV), D, 32 * nb, 32 * (nb & 15), 32, 64 * kb, scr, lane);
            }
    } while (0);
}

__global__ void __launch_bounds__(NWAVES * 64, 2) mega_fwd(Args args) {
    extern __shared__ __attribute__((aligned(16))) unsigned char lds[];
    LAS unsigned char* const ldsl = (LAS unsigned char*)lds;
    volatile LAS unsigned* const MISC = (volatile LAS unsigned*)(ldsl + MISC_OFF);
    const int G = gridDim.x; const int bx = blockIdx.x; const int vcu = (G % 8 == 0) ? (bx % 8) * (G / 8) + bx / 8 : bx;
    unsigned char* const ws = args.ws;
    gu32* const ctl = (gu32*)(ws + WS_CTL);
    const float* x = args.in[0]; const float* mem = args.in[1]; const float* norm_mix = args.in[2]; const float* norm_mem = args.in[3]; const float* norm_ffn = args.in[4]; const float* norm_final = args.in[5];
    const float* w_in_fox = args.in[6]; const float* b_fgate = args.in[7]; const float* w_in_moba = args.in[8]; const float* w_mem_kv = args.in[9]; const float* w_out = args.in[10];
    const float* w_gate_up = args.in[11]; const float* w_down = args.in[12];
    float* const out = args.out;
    float* const SSQA = (float*)(ws + WS_SSQA); float* const SSQB = (float*)(ws + WS_SSQB); float* const RSTDM = (float*)(ws + WS_RSTDM); float* const LF = (float*)(ws + WS_LF);
    bf16* const MKV = (bf16*)(ws + WS_MKV); bf16* const MEMB = (bf16*)(ws + WS_MEMB); bf16* const HB = (bf16*)(ws + WS_HB);
    bf16* const Qb = (bf16*)(ws + WS_Q); bf16* const Kb = (bf16*)(ws + WS_K); bf16* const Vb = (bf16*)(ws + WS_V); bf16* const QMb = (bf16*)(ws + WS_QM); bf16* const HEADS = (bf16*)(ws + WS_HEADS); bf16* const ACT = (bf16*)(ws + WS_ACT);
    for (int u = threadIdx.x; u < (LDS_BYTES - LDSCTL_OFF) / 4; u += NWAVES * 64) ((LAS unsigned*)(ldsl + LDSCTL_OFF))[u] = 0u;
    __syncthreads();
    const int lo = args.ph_lo, hi = args.ph_hi;
    XcdBarrier bar; bar.bar = (unsigned*)(ctl + CW_BAR); bar.x = 0; bar.st = nullptr;
    if (hi - lo > 1) bar = xcd_barrier_post((unsigned*)(ctl + CW_BAR), MISC + 8);
#define IN(k) (lo <= (k) && (k) < hi)
#define SEAM(k) do { if (IN(k) && IN((k) + 1)) xcd_barrier(bar); } while (0)

    if (IN(0)) {
        int tid_ = threadIdx.x; asm volatile("" : "+v"(tid_)); const int lane = tid_ & 63, wave = __builtin_amdgcn_readfirstlane(tid_ >> 6);
        LAS float* scr = (LAS float*)(ldsl + RING_OFF + wave * 16384);
        const int gw = vcu * NWAVES + wave, NGW = G * NWAVES;
        const ConvSrc cs{w_in_fox, w_in_moba, norm_mix, w_out, w_gate_up, norm_ffn, w_down, w_mem_kv, norm_mem};
        for (int it = gw; it < NITEMS; it += NGW) { if (it >= I_IN && it < 4 * I_L) continue; conv_dispatch(it, cs, ws, scr, lane); }
        for (int m = gw; m < M + MROWS; m += NGW) {
            const bool ismem = m >= M; const int row = ismem ? m - M : m;
            const GAS f32x4* xr = (const GAS f32x4*)((ismem ? mem : x) + (size_t)row * D) + lane;
            f32x4 v[4]; float s = 0.f;
#pragma unroll
            for (int j = 0; j < 4; ++j) { v[j] = xr[64 * j]; s += (v[j].x * v[j].x + v[j].y * v[j].y) + (v[j].z * v[j].z + v[j].w * v[j].w); }
            s = wave_sum(s);
            GAS unsigned long long* o8 = (GAS unsigned long long*)((ismem ? MEMB : HB) + (size_t)row * D) + lane;
#pragma unroll
            for (int j = 0; j < 4; ++j) o8[64 * j] = (unsigned long long)pk2(v[j].x, v[j].y) | ((unsigned long long)pk2(v[j].z, v[j].w) << 32);
            if (ismem) { if (lane == 0) RSTDM[row] = rsqrtf(s * (1.f / D) + RMS_EPS); }
            else if (lane < 16) SSQA[(size_t)row * 16 + lane] = (lane == 0) ? s : 0.f;
        }
    }
    SEAM(0);

    for (int L = 0; L < DEPTH; ++L) {
        const int pbase = 1 + 7 * L; const bool fox = (L & 1) == 0; const int j = L >> 1;
        const unsigned char* wl = ws + WS_W + (size_t)L * WL_STRIDE;
        float* const KMEAN = (float*)(ws + WS_KMEAN + (size_t)j * KMEAN_STRIDE);
        if (IN(pbase)) {
            pg8::Gemm g{(const pg8::bf16_t*)HB, (const pg8::bf16_t*)(wl + WL_IN), M, fox ? NPROJ_FOX : NPROJ_MOBA, D}; pg8::StaticOrder S; S.init(M, g.N, G, bx);
            pg8::EpiProj E{Qb, Kb, Vb, QMb, fox ? nullptr : KMEAN, SSQA, (float*)(ctl + CW_NMAX + 256 * L)};
            pg8::gemm_phase<pg8::EpiProj, pg8::StaticOrder, true, true>(ldsl + RING_OFF, g, S, E);
            if (fox) { int t3_ = threadIdx.x; asm volatile("" : "+v"(t3_)); const int wv3 = __builtin_amdgcn_readfirstlane(t3_ >> 6);
                for (int jb = vcu * NWAVES + wv3; jb < M / 16; jb += G * NWAVES) flogit_job(HB, (const bf16*)(wl + WL_IN) + (size_t)2560 * D, SSQA, b_fgate + (size_t)j * NSH, LF, 16 * jb, t3_ & 63); }
            if (L == 0) {
                pg8::Gemm g2{(const pg8::bf16_t*)MEMB, (const pg8::bf16_t*)(ws + WS_W + W_MKV), MROWS, 2048, D}; pg8::StaticOrder S2; S2.init(MROWS, 2048, G, (G == 256) ? ((bx + 128) & 255) : bx);
                pg8::EpiMkv E2{MKV, RSTDM};
                pg8::gemm_phase<pg8::EpiMkv, pg8::StaticOrder, true, true>(ldsl + RING_OFF, g2, S2, E2);
            }
        }
        SEAM(pbase);
#define ATT_SETUP(sub) \
            char* const shm = (char*)lds + RING_OFF; \
            int tid_ = threadIdx.x; asm volatile("" : "+v"(tid_)); \
            if (tid_ < NSH) { const int h_ = tid_; int rank = 0; \
                if (fox) { const float bh_ = b_fgate[(size_t)j * NSH + h_]; for (int k = 0; k < NSH; ++k) { const float bk = b_fgate[(size_t)j * NSH + k]; rank += (bk > bh_ || (bk == bh_ && k < h_)) ? 1 : 0; } } \
                else rank = NSH - 1 - h_; \
                MISC[16 + rank] = (unsigned)h_; } \
            __syncthreads(); \
            gu32* const qctr = ctl + CW_QUEUE + 64 * (3 * L + (sub)); \
            int prev_bh = -1; (void)prev_bh; const int wv = __builtin_amdgcn_readfirstlane(tid_ >> 6); (void)wv; bool first_ = true
#define DEQ(var) do { if (first_) { first_ = false; var = bx; } else { if (tid_ == 0) MISC[0] = (unsigned)G + __hip_atomic_fetch_add(qctr, 1u, RLX_AGENT); __syncthreads(); var = __builtin_amdgcn_readfirstlane((int)MISC[0]); __syncthreads(); } } while (0)
        unsigned* const CNTL = (unsigned*)(ctl + CW_CNT + 2048 * j);
        unsigned* const LIST = (unsigned*)((unsigned char*)out + OUT_LIST); unsigned* const ENT = (unsigned*)(ws + WS_ENT); float* const MLB = (float*)(ws + WS_ML);
#define PART_BH(bh) ((bh) < 24 ? (bf16*)out + (size_t)(bh) * PART_PER_BH * HD : (bf16*)(ws + WS_PARTB) + (size_t)((bh) - 24) * PART_PER_BH * HD)
        if (!fox && IN(pbase + 1)) {
            ATT_SETUP(0); float thr = 0.f;
            for (;;) { int i; DEQ(i); if (i >= 1536) break;
                const int hr = i >> 7, b = (i >> 5) & 3, qb = i & 31, h = __builtin_amdgcn_readfirstlane((int)MISC[16 + hr]), bh = b * NSH + h;
                const float sl2 = exp2f(-8.0f * (float)(h + 1) / (float)NSH) * LOG2E;
                if (bh != prev_bh) { prev_bh = bh; attn_body::build_tabs_moba(sl2, KMEAN + (size_t)b * NBLK * SELFW + h * HD, shm); thr = attn_body::thr_from_nmax((const float*)(ctl + CW_NMAX + 256 * L) + 4 * bh); }
                attn_body::moba_route_lists(Qb + ((size_t)b * T + (size_t)qb * 256) * SELFW + h * HD, SELFW, qb, sl2, attn_body::skip_eff(thr), CNTL + bh * 32, LIST + (size_t)bh * 31 * 8192, ENT + (size_t)bh * 8192 * 4, shm);
            }
        }
        if (!fox) SEAM(pbase + 1);
        if (!fox && IN(pbase + 2)) {
            ATT_SETUP(1);
            volatile LAS unsigned* const SP = (volatile LAS unsigned*)(ldsl + RING_OFF + attn_body::KM_OFF); volatile LAS unsigned* const RP = (volatile LAS unsigned*)(ldsl + RING_OFF + attn_body::SEL_OFF);
            volatile LAS unsigned* const CA = (volatile LAS unsigned*)(ldsl + RING_OFF + attn_body::ALLT_OFF); volatile LAS unsigned* const BA = CA + 1536;
            for (int idx = tid_; idx < 1536; idx += NWAVES * 64) { const int hb_ = idx >> 5, jj = idx & 31, bh_ = (hb_ & 3) * NSH + (int)MISC[16 + (hb_ >> 2)];
                const unsigned c = (jj < 31) ? __hip_atomic_load(CNTL + bh_ * 32 + jj, __ATOMIC_RELAXED, __HIP_MEMORY_SCOPE_AGENT) : 0u; CA[idx] = c; SP[idx] = (c + 1023u) >> 10; }
            __syncthreads();
            if (tid_ < 48) { unsigned run = 0, eb = 0; for (int jj = 0; jj < 32; ++jj) { BA[tid_ * 32 + jj] = eb; eb += CA[tid_ * 32 + jj]; run += SP[tid_ * 32 + jj]; SP[tid_ * 32 + jj] = run; } RP[tid_ + 1] = run; }
            __syncthreads();
            if (tid_ == 0) { unsigned run = 0; RP[0] = 0u; for (int r = 1; r <= 48; ++r) { run += RP[r]; RP[r] = run; } }
            __syncthreads();
            const int nslots = __builtin_amdgcn_readfirstlane((int)RP[48]);
            for (;;) { int i; DEQ(i); if (i >= nslots) break;
                int hb = 0; for (int st = 32; st > 0; st >>= 1) { const int r = hb + st; if (r < 48 && (int)RP[r] <= i) hb = r; }
                hb = __builtin_amdgcn_readfirstlane(hb); const int li = i - __builtin_amdgcn_readfirstlane((int)RP[hb]);
                int jb = 0; for (int st = 16; st > 0; st >>= 1) { const int r = jb + st; if (r < 32 && (int)SP[hb * 32 + r - 1] <= li) jb = r; }
                jb = __builtin_amdgcn_readfirstlane(jb); const int g_ = li - (jb ? __builtin_amdgcn_readfirstlane((int)SP[hb * 32 + jb - 1]) : 0);
                const int hr = hb >> 2, b = hb & 3, h = __builtin_amdgcn_readfirstlane((int)MISC[16 + hr]), bh = b * NSH + h;
                const float sl2 = exp2f(-8.0f * (float)(h + 1) / (float)NSH) * LOG2E;
                const int cnt = (int)CA[hb * 32 + jb], basej = (int)BA[hb * 32 + jb];
                const int cntu = __builtin_amdgcn_readfirstlane(cnt), baseu = __builtin_amdgcn_readfirstlane(basej);
                if (1024 * g_ >= cntu) continue;
                const bf16* kh = Kb + (size_t)b * T * SELFW + h * HD; const bf16* vh = Vb + (size_t)b * T * SELFW + h * HD;
                attn_body::load_block_kv(kh, vh, SELFW, jb, sl2, shm);
                const float thrb = attn_body::thr_from_nmax((const float*)(ctl + CW_NMAX + 256 * L) + 4 * bh), m0b = (thrb - 150.0f) * 0.5f;
                const bool stb = __builtin_amdgcn_readfirstlane(thrb < 210.0f ? 1 : 0) != 0;
                const int nw = (cntu + 31) >> 5, wend = (32 * g_ + 32 < nw) ? 32 * g_ + 32 : nw;
                for (int wc = 32 * g_ + wv; wc < wend; wc += NWAVES) {
                    const int e0 = baseu + 32 * wc; attn_body::AttnAux ax{LIST + ((size_t)bh * 31 + jb) * 8192 + 32 * wc, MLB + ((size_t)bh * PART_PER_BH + e0) * 2, nullptr, nullptr, nullptr, sl2, (cntu - 32 * wc) < 32 ? (cntu - 32 * wc) : 32, 0, 0};
                    if (stb) attn_body::attn_unit<3, 24, true, true>(Qb + (size_t)b * T * SELFW + h * HD, SELFW, kh, vh, SELFW, PART_BH(bh) + (size_t)e0 * HD, HD, 4, 0, shm, ax, m0b);
                    else attn_body::attn_unit<3, 24, true>(Qb + (size_t)b * T * SELFW + h * HD, SELFW, kh, vh, SELFW, PART_BH(bh) + (size_t)e0 * HD, HD, 4, 0, shm, ax);
                }
            }
        }
        if (!fox) SEAM(pbase + 2);
        if (IN(pbase + 3)) {
            ATT_SETUP(2);
            if (!fox) {
                volatile LAS unsigned* const CA = (volatile LAS unsigned*)(ldsl + RING_OFF + attn_body::ALLT_OFF); volatile LAS unsigned* const BA = CA + 1536;
                for (int idx = tid_; idx < 1536; idx += NWAVES * 64) { const int hb_ = idx >> 5, jj = idx & 31, bh_ = (hb_ & 3) * NSH + (int)MISC[16 + (hb_ >> 2)];
                    CA[idx] = (jj < 31) ? __hip_atomic_load(CNTL + bh_ * 32 + jj, __ATOMIC_RELAXED, __HIP_MEMORY_SCOPE_AGENT) : 0u; }
                __syncthreads();
                if (tid_ < 48) { unsigned eb = 0; for (int jj = 0; jj < 32; ++jj) { BA[tid_ * 32 + jj] = eb; eb += CA[tid_ * 32 + jj]; } }
                __syncthreads();
            }
            const int nself = (args.flags & 1) ? (fox ? 768 : 1536) : 0, nmem = (args.flags & 2) ? 128 : 0; float thr = 0.f;
            const int nconv = (L == 0) ? (4 * I_L - I_IN + 63) / 64 : 0;
            const ConvSrc cs{w_in_fox, w_in_moba, norm_mix, w_out, w_gate_up, norm_ffn, w_down, w_mem_kv, norm_mem};
            for (;;) { int i;
                DEQ(i); if (i >= nself + nmem + nconv) break;
                if (i >= nself + nmem) { LAS float* scr = (LAS float*)(ldsl + RING_OFF + wv * 16384);
                    int tc_ = threadIdx.x; asm volatile("" : "+v"(tc_));
                    for (int k = 0; k < 8; ++k) { const int it = I_IN + (i - nself - nmem) * 64 + wv * 8 + k; if (it < 4 * I_L) conv_dispatch(it, cs, ws, scr, tc_ & 63); }
                    prev_bh = -1; continue; }
                if (i < nself && fox) {
                    const int hr = i >> 6, b = (i >> 4) & 3, s = i & 15, h = __builtin_amdgcn_readfirstlane((int)MISC[16 + hr]), bh = b * NSH + h;
                    if (bh != prev_bh) { prev_bh = bh; attn_body::build_gtab_fox(LF + (size_t)bh * T, shm); thr = attn_body::thr_from_nmax((const float*)(ctl + CW_NMAX + 256 * L) + 4 * bh); }
                    for (int k = 0; k < 2; ++k) { const int qb = k ? 31 - s : s; const size_t row0 = (size_t)b * T + (size_t)qb * 256;
                        const int t0 = attn_body::tile_start(shm, 4 * qb + 4, attn_body::skip_eff(thr));
                        if (__builtin_amdgcn_readfirstlane(thr < 210.0f ? 1 : 0)) attn_body::attn_unit<0, 24, false, true>(Qb + row0 * SELFW + h * HD, SELFW, Kb + (size_t)b * T * SELFW + h * HD, Vb + (size_t)b * T * SELFW + h * HD, SELFW, HEADS + row0 * D + h * HD, D, 4 * qb + 4, t0, shm, attn_body::AttnAux{}, (thr - 150.0f) * 0.5f);
                        else attn_body::attn_unit<0, 24>(Qb + row0 * SELFW + h * HD, SELFW, Kb + (size_t)b * T * SELFW + h * HD, Vb + (size_t)b * T * SELFW + h * HD, SELFW, HEADS + row0 * D + h * HD, D, 4 * qb + 4, t0, shm);
                    }
                } else if (i < nself) {
                    const int hr = i >> 7, b = (i >> 5) & 3, qb = i & 31, h = __builtin_amdgcn_readfirstlane((int)MISC[16 + hr]), bh = b * NSH + h; const size_t row0 = (size_t)b * T + (size_t)qb * 256;
                    const float sl2 = exp2f(-8.0f * (float)(h + 1) / (float)NSH) * LOG2E;
                    const bf16* kh = Kb + (size_t)b * T * SELFW + h * HD; const bf16* vh = Vb + (size_t)b * T * SELFW + h * HD;
                    attn_body::load_block_kv(kh, vh, SELFW, qb, sl2, shm);
                    attn_body::AttnAux ax{nullptr, nullptr, ENT + ((size_t)bh * 8192 + (size_t)qb * 256) * 4, PART_BH(bh), MLB + (size_t)bh * PART_PER_BH * 2, sl2, 0, attn_body::ALLT_OFF + (1536 + (hr * 4 + b) * 32) * 4, 0};
                    const float thro = attn_body::thr_from_nmax((const float*)(ctl + CW_NMAX + 256 * L) + 4 * bh);
                    if (__builtin_amdgcn_readfirstlane(thro < 210.0f ? 1 : 0)) attn_body::attn_unit<4, 24, true, true>(Qb + row0 * SELFW + h * HD, SELFW, kh, vh, SELFW, HEADS + row0 * D + h * HD, D, 4, 0, shm, ax, (thro - 150.0f) * 0.5f);
                    else attn_body::attn_unit<4, 24, true>(Qb + row0 * SELFW + h * HD, SELFW, kh, vh, SELFW, HEADS + row0 * D + h * HD, D, 4, 0, shm, ax);
                } else {
                    const int u = i - nself, b = u >> 5, hm = (u >> 3) & 3, g2 = u & 7;
                    const bf16* kh = MKV + (size_t)b * NMEM * 2048 + L * 512 + hm * HD;
                    attn_body::load_block_kv(kh, kh + 256, 2048, 0, 0.f, shm); prev_bh = -1;
                    for (int k = 0; k < 4; ++k) { const size_t row0 = (size_t)b * T + (size_t)(4 * g2 + k) * 256;
                        attn_body::attn_unit<2, 8, true>(QMb + row0 * MEMW + hm * HD, MEMW, kh, kh + 256, 2048, HEADS + row0 * D + SELFW + hm * HD, D, 4, 0, shm); }
                }
            }
        }
        SEAM(pbase + 3);
#undef ATT_SETUP
#undef DEQ
#undef PART_BH
        if (IN(pbase + 4)) {
            pg8::Gemm g{(const pg8::bf16_t*)HEADS, (const pg8::bf16_t*)(wl + WL_OUT), M, D, D}; pg8::StaticOrder S; S.init(M, D, G, bx);
            pg8::EpiRes E{HB, SSQB};
            pg8::gemm_phase<pg8::EpiRes, pg8::StaticOrder, true, true>(ldsl + RING_OFF, g, S, E);
        }
        SEAM(pbase + 4);
        if (IN(pbase + 5)) {
            pg8::Gemm g{(const pg8::bf16_t*)HB, (const pg8::bf16_t*)(wl + WL_GU), M, 2 * DFF, D}; pg8::StaticOrder S; S.init(M, 2 * DFF, G, bx);
            pg8::EpiSwi E{ACT, SSQB};
            pg8::gemm_phase<pg8::EpiSwi, pg8::StaticOrder, true, true>(ldsl + RING_OFF, g, S, E);
        }
        SEAM(pbase + 5);
        if (IN(pbase + 6)) {
            pg8::Gemm g{(const pg8::bf16_t*)ACT, (const pg8::bf16_t*)(wl + WL_DN), M, D, DFF}; pg8::StaticOrder S; S.init(M, D, G, bx);
            pg8::EpiRes E{HB, SSQA};
            pg8::gemm_phase<pg8::EpiRes, pg8::StaticOrder, true, true>(ldsl + RING_OFF, g, S, E);
        }
        SEAM(pbase + 6);
    }
    if (IN(29)) {
        int tid_ = threadIdx.x; asm volatile("" : "+v"(tid_)); const int lane = tid_ & 63, wave = __builtin_amdgcn_readfirstlane(tid_ >> 6);
        const int gw = vcu * NWAVES + wave, NGW = G * NWAVES;
        const unsigned poison = __hip_atomic_load((gu32*)((unsigned*)(ctl + CW_BAR) + XB_TMO), RLX_AGENT);
        for (int m = gw; m < M; m += NGW) {
            float s = (lane < 16) ? SSQA[(size_t)m * 16 + lane] : 0.f; s = wave_sum(s);
            float rstd = rsqrtf(s * (1.f / D) + RMS_EPS); if (poison) rstd = __builtin_nanf("");
            GAS f32x4* p = (GAS f32x4*)(out + (size_t)m * D) + lane; const GAS f32x4* g4 = (const GAS f32x4*)norm_final + lane;
            const GAS unsigned long long* hp = (const GAS unsigned long long*)(HB + (size_t)m * D) + lane;
#pragma unroll
            for (int jj = 0; jj < 4; ++jj) { const unsigned long long w = hp[64 * jj]; const unsigned lo_ = (unsigned)w, hi_ = (unsigned)(w >> 32);
                f32x4 v = {__uint_as_float(lo_ << 16), __uint_as_float(lo_ & 0xffff0000u), __uint_as_float(hi_ << 16), __uint_as_float(hi_ & 0xffff0000u)};
                const f32x4 gg = g4[64 * jj]; v = v * gg * rstd; p[64 * jj] = v; }
        }
    }
#undef IN
#undef SEAM
}

extern "C" void kernel_launch(void* const* d_in, const int* in_sizes, int n_in, void* d_out, int out_size, void* d_ws, size_t ws_size, hipStream_t stream) {
    static int grid = 0;
    if (grid == 0) {
        if (n_in != 13 || in_sizes[0] != M * D || out_size != M * D || ws_size < WS_END3) { fprintf(stderr, "kernel_launch: unexpected shapes (n_in %d, ws %zu)\n", n_in, ws_size); grid = -1; return; }
        int dev = 0, cus = 0, per_cu = 0;
        if (hipGetDevice(&dev) != hipSuccess || hipDeviceGetAttribute(&cus, hipDeviceAttributeMultiprocessorCount, dev) != hipSuccess) { grid = -1; return; }
        if (hipFuncSetAttribute((const void*)mega_fwd, hipFuncAttributeMaxDynamicSharedMemorySize, LDS_BYTES) != hipSuccess) { fprintf(stderr, "kernel_launch: hipFuncSetAttribute failed\n"); grid = -1; return; }
        if (hipOccupancyMaxActiveBlocksPerMultiprocessor(&per_cu, (const void*)mega_fwd, NWAVES * 64, LDS_BYTES) != hipSuccess || per_cu < 1) fprintf(stderr, "kernel_launch: occupancy query reports %d\n", per_cu);
        (void)hipGetLastError();
        grid = cus;
    }
    if (grid < 0) return;
    unsigned char* ws = (unsigned char*)d_ws; float* out = (float*)d_out;
    (void)hipMemsetAsync(ws + WS_CTL, 0, CTL_ZERO_BYTES, stream);
    Args a{};
    for (int i = 0; i < 13; ++i) a.in[i] = (const float*)d_in[i];
    a.out = out; a.ws = ws; a.flags = 3; a.pad = 0;
    a.ph_lo = 0; a.ph_hi = N_PHASES;
    hipLaunchKernelGGL(mega_fwd, dim3(grid), dim3(NWAVES * 64), LDS_BYTES, stream, a);
}
```

```cpp
#include <hip/hip_runtime.h>
#include <cstdio>
#include <cstdint>

constexpr int BATCH = 4, T = 8192, D = 1024, M = BATCH * T;
constexpr int NSH = 12, NMH = 4, HD = 64, SELFW = NSH * HD, MEMW = NMH * HD;
constexpr int NMEM = 256, MROWS = BATCH * NMEM;
constexpr int DFF = 2816, DEPTH = 4;
constexpr int FOXP = 3 * SELFW + NSH + MEMW;
constexpr int MOBAP = 3 * SELFW + MEMW;
constexpr int NBLK = T / 256;
constexpr float RMS_EPS = 1e-6f;
constexpr float LOG2E = 1.4426950408889634f;
constexpr float C2 = 0.125f * LOG2E;

constexpr size_t MiB = 1u << 20;
constexpr size_t WS_CTL = 0, CTL_ZERO_BYTES = 2 * MiB;
constexpr size_t WS_KMEAN = 1 * MiB;
constexpr size_t KMEAN_STRIDE = 512 * 1024;
constexpr size_t WS_SSQA = 2 * MiB, WS_SSQB = 4 * MiB;
constexpr size_t WS_RSTDM = 6 * MiB;
constexpr size_t WS_LF = 7 * MiB;
constexpr size_t WS_G = 8 * MiB + 512 * 1024;
constexpr size_t WS_MKV = 10 * MiB;
constexpr size_t WS_MEMB = 14 * MiB;
constexpr size_t WS_W = 16 * MiB;
constexpr size_t WS_HB = 116 * MiB;
constexpr size_t WS_Q = 180 * MiB, WS_K = 228 * MiB, WS_V = 276 * MiB, WS_QM = 324 * MiB, WS_HEADS = 340 * MiB;
constexpr size_t WS_ACT = 180 * MiB;
constexpr size_t WS_END = 404 * MiB;

typedef unsigned short bf16;
__device__ __forceinline__ float bf2f(bf16 v) { return __uint_as_float(((unsigned)v) << 16); }
__device__ __forceinline__ bf16 f2bf(float f) { unsigned u = __float_as_uint(f); return (bf16)((u + 0x7fffu + ((u >> 16) & 1u)) >> 16); }
__device__ __forceinline__ float wave_sum(float v) {
#pragma unroll
    for (int o = 1; o < 64; o <<= 1) v += __shfl_xor(v, o);
    return v;
}

namespace pg8 {
#define PG8_LAS __attribute__((address_space(3)))
typedef unsigned short bf16_t;
typedef short bf16x8 __attribute__((ext_vector_type(8)));
typedef float f32x4 __attribute__((ext_vector_type(4)));
typedef unsigned u32x4 __attribute__((ext_vector_type(4)));
constexpr int BM = 256, BK = 64, HALF = 128, HTB = HALF * BK * 2  , STAGE_BYTES = 8 * HTB, NXCD = 8, WGM = 8;

__host__ __device__ __forceinline__ int lds_byte(int r, int c) { const int st = (r >> 4) * 2 + (c >> 5), rr = r & 15, cc = c & 31, ob = rr * 64 + cc * 2; return st * 1024 + (ob ^ (((ob >> 9) & 1) << 5)); }
__host__ __device__ __forceinline__ void stage_rc(int b, int& R, int& C) { const int st = b / 1024, sb = b % 1024, swz = sb ^ (((sb >> 9) & 1) << 5); R = (st >> 1) * 16 + swz / 64; C = (st & 1) * 32 + (swz % 64) / 2; }
__host__ __device__ __forceinline__ int perm32(int rho) { const int n = rho >> 4, i = rho & 15; return 8 * (i >> 2) + 4 * n + (i & 3); }

struct Unit { int pm, pn; };
struct Gemm { const bf16_t* A; const bf16_t* Bt; int M, N, K; };

struct StaticOrder {
    int nM, nN, nwg, G, c;
    __host__ __device__ void init(int M, int N, int G_, int c_) { nM = M / BM; nN = N / BM; nwg = nM * nN; G = G_; c = c_; }
    __host__ __device__ bool next(int i, Unit& u) const {
        const long L = (long)i * G + c; if (L >= nwg) return false;
        int wgid = (int)L; { const int q = nwg / NXCD, r = nwg % NXCD, xcd = wgid % NXCD, off = wgid / NXCD; wgid = (xcd < r ? xcd * (q + 1) : r * (q + 1) + (xcd - r) * q) + off; }
        const int nig = WGM * nN, gid = wgid / nig, fm = gid * WGM, gsz = (nM - fm) < WGM ? (nM - fm) : WGM;
        u.pm = fm + ((wgid % nig) % gsz); u.pn = (wgid % nig) / gsz; return true;
    }
    __device__ __forceinline__ void a_ready(const Unit&) const {}
    __device__ __forceinline__ void done(const Unit&) const {}
};

__device__ __forceinline__ unsigned cvt_pk_bf16(float lo, float hi) { unsigned r; asm volatile("v_cvt_pk_bf16_f32 %0, %1, %2" : "=v"(r) : "v"(lo), "v"(hi)); return r; }
typedef float f32x2 __attribute__((ext_vector_type(2)));
constexpr float kEps = 1e-6f, kLog2e = 1.4426950408889634f, kC2 = 0.125f * 1.4426950408889634f;
__device__ __forceinline__ void row_rstd(const float* ssq, int row0, int fq, float (&rs)[2][4]) {
#pragma unroll
    for (int ai = 0; ai < 2; ++ai)
#pragma unroll
        for (int m = 0; m < 4; ++m) { const f32x4 p = *(const f32x4*)(ssq + (size_t)(row0 + ai * HALF + m * 16) * 16 + 4 * fq);
            float s = (p[0] + p[1]) + (p[2] + p[3]); s += __shfl_xor(s, 16); s += __shfl_xor(s, 32); rs[ai][m] = rsqrtf(s * (1.0f / 1024.0f) + kEps); }
}
__device__ __forceinline__ u32x4 pack8(const f32x4 v0, const f32x4 v1) { u32x4 w; w.x = cvt_pk_bf16(v0[0], v0[1]); w.y = cvt_pk_bf16(v0[2], v0[3]); w.z = cvt_pk_bf16(v1[0], v1[1]); w.w = cvt_pk_bf16(v1[2], v1[3]); return w; }

struct EpiProj {
    static constexpr bool PERM = true, AFTER_DRAIN = false, CINIT = false;
    bf16_t *Q, *K, *V, *QM; float* kmean; const float* ssq; float* nmax;
    __device__ __forceinline__ void operator()(const f32x4 (&acc)[2][2][4][2], const Unit& u, int wr, int wc, int fr, int fq) const {
        const int row0 = u.pm * BM + wr * 64 + fr, pn = u.pn;
        float rs[2][4]; row_rstd(ssq, row0, fq, rs);
        if (pn <= 9) {
            bf16_t* base; int ld = 768, coff; float sc = 1.f;
            if (pn < 3) { base = Q; coff = pn * 256; sc = kC2; } else if (pn < 6) { base = K; coff = (pn - 3) * 256; } else if (pn < 9) { base = V; coff = (pn - 6) * 256; } else { base = QM; ld = 256; coff = 0; sc = kC2; }
            const int col0 = coff + wc * 32 + 8 * fq; float mx[2] = {0.f, 0.f};
#pragma unroll
            for (int ai = 0; ai < 2; ++ai)
#pragma unroll
                for (int m = 0; m < 4; ++m) { const int row = row0 + ai * HALF + m * 16; bf16_t* rowp = base + (size_t)row * ld + col0; const float f = rs[ai][m] * sc;
#pragma unroll
                    for (int bj = 0; bj < 2; ++bj) { const f32x4 v0 = acc[ai][bj][m][0] * f, v1 = acc[ai][bj][m][1] * f; *(u32x4*)(rowp + bj * HALF) = pack8(v0, v1);
                        if (pn < 6) { float q = (v0[0] * v0[0] + v0[1] * v0[1]) + (v0[2] * v0[2] + v0[3] * v0[3]) + (v1[0] * v1[0] + v1[1] * v1[1]) + (v1[2] * v1[2] + v1[3] * v1[3]);
                            q += __shfl_xor(q, 16); q += __shfl_xor(q, 32); mx[bj] = fmaxf(mx[bj], q); } } }
            if (pn < 6) {
#pragma unroll
                for (int bj = 0; bj < 2; ++bj) { float v = mx[bj]; v = fmaxf(v, __shfl_xor(v, 1)); v = fmaxf(v, __shfl_xor(v, 2)); v = fmaxf(v, __shfl_xor(v, 4)); v = fmaxf(v, __shfl_xor(v, 8));
                    if (fr == 0 && fq == 0) atomicMax((unsigned*)nmax + ((size_t)(u.pm >> 5) * 12 + (coff >> 6) + bj * 2 + (wc >> 1)) * 4 + (pn < 3 ? 0 : 2) + (wc & 1), __float_as_uint(v)); } }
            if (kmean && pn >= 3 && pn < 6) {
#pragma unroll
                for (int bj = 0; bj < 2; ++bj)
#pragma unroll
                    for (int n = 0; n < 2; ++n) { f32x4 s = {0.f, 0.f, 0.f, 0.f};
#pragma unroll
                        for (int ai = 0; ai < 2; ++ai)
#pragma unroll
                            for (int m = 0; m < 4; ++m) s += acc[ai][bj][m][n] * rs[ai][m];
#pragma unroll
                        for (int j = 0; j < 4; ++j) { float t = s[j]; t += __shfl_xor(t, 1); t += __shfl_xor(t, 2); t += __shfl_xor(t, 4); t += __shfl_xor(t, 8);
                            if (fr == 0) atomicAdd(kmean + (size_t)u.pm * 768 + col0 + bj * HALF + 4 * n + j, t * (1.0f / 256.0f)); } }
            }
        }
    }
};
struct EpiMkv {
    static constexpr bool PERM = true, AFTER_DRAIN = false, CINIT = false;
    bf16_t* MKV; const float* rstd;
    __device__ __forceinline__ void operator()(const f32x4 (&acc)[2][2][4][2], const Unit& u, int wr, int wc, int fr, int fq) const {
        const int row0 = u.pm * BM + wr * 64 + fr, col0 = u.pn * BM + wc * 32 + 8 * fq;
#pragma unroll
        for (int ai = 0; ai < 2; ++ai)
#pragma unroll
            for (int m = 0; m < 4; ++m) { const int row = row0 + ai * HALF + m * 16; const float f = rstd[row]; bf16_t* rowp = MKV + (size_t)row * 2048 + col0;
#pragma unroll
                for (int bj = 0; bj < 2; ++bj) *(u32x4*)(rowp + bj * HALF) = pack8(acc[ai][bj][m][0] * f, acc[ai][bj][m][1] * f); }
    }
};
struct EpiRes {
    static constexpr bool PERM = true, AFTER_DRAIN = false, CINIT = true;
    bf16_t* hb; float* ssq;
    __device__ __forceinline__ void cinit(f32x4 (&acc)[2][2][4][2], const Unit& u, int wr, int wc, int fr, int fq) const {
        const int row0 = u.pm * BM + wr * 64 + fr, col0 = u.pn * BM + wc * 32 + 8 * fq;
#pragma unroll
        for (int ai = 0; ai < 2; ++ai)
#pragma unroll
            for (int m = 0; m < 4; ++m)
#pragma unroll
                for (int bj = 0; bj < 2; ++bj) { const u32x4 o = *(const u32x4*)(hb + (size_t)(row0 + ai * HALF + m * 16) * 1024 + col0 + bj * HALF);
                    acc[ai][bj][m][0] = (f32x4){__uint_as_float(o.x << 16), __uint_as_float(o.x & 0xffff0000u), __uint_as_float(o.y << 16), __uint_as_float(o.y & 0xffff0000u)};
                    acc[ai][bj][m][1] = (f32x4){__uint_as_float(o.z << 16), __uint_as_float(o.z & 0xffff0000u), __uint_as_float(o.w << 16), __uint_as_float(o.w & 0xffff0000u)}; }
    }
    __device__ __forceinline__ void operator()(const f32x4 (&acc)[2][2][4][2], const Unit& u, int wr, int wc, int fr, int fq) const {
        const int row0 = u.pm * BM + wr * 64 + fr, col0 = u.pn * BM + wc * 32 + 8 * fq;
#pragma unroll
        for (int ai = 0; ai < 2; ++ai)
#pragma unroll
            for (int m = 0; m < 4; ++m) { const int row = row0 + ai * HALF + m * 16; const size_t off = (size_t)row * 1024 + col0; float s = 0.f;
#pragma unroll
                for (int bj = 0; bj < 2; ++bj) { const f32x4 v0 = acc[ai][bj][m][0], v1 = acc[ai][bj][m][1];
                    *(u32x4*)(hb + off + bj * HALF) = pack8(v0, v1);
                    s += (v0[0] * v0[0] + v0[1] * v0[1]) + (v0[2] * v0[2] + v0[3] * v0[3]) + (v1[0] * v1[0] + v1[1] * v1[1]) + (v1[2] * v1[2] + v1[3] * v1[3]); }
                s += __shfl_xor(s, 16); s += __shfl_xor(s, 32);
                if (fq == 0) ssq[(size_t)row * 16 + u.pn * 4 + wc] = s; }
    }
};
struct EpiSwi {
    static constexpr bool PERM = true, AFTER_DRAIN = false, CINIT = false;
    bf16_t* ACT; const float* ssq;
    __device__ __forceinline__ void operator()(const f32x4 (&acc)[2][2][4][2], const Unit& u, int wr, int wc, int fr, int fq) const {
        const int row0 = u.pm * BM + wr * 64 + fr, col0 = u.pn * HALF + wc * 32 + 8 * fq;
        float rs[2][4]; row_rstd(ssq, row0, fq, rs);
#pragma unroll
        for (int ai = 0; ai < 2; ++ai)
#pragma unroll
            for (int m = 0; m < 4; ++m) { const float f = rs[ai][m]; f32x4 a[2];
#pragma unroll
                for (int n = 0; n < 2; ++n) { const f32x4 g = acc[ai][0][m][n] * f, up = acc[ai][1][m][n] * f;
#pragma unroll
                    for (int j = 0; j < 4; ++j) a[n][j] = g[j] * __builtin_amdgcn_rcpf(1.0f + __builtin_amdgcn_exp2f(-kLog2e * g[j])) * up[j]; }
                *(u32x4*)(ACT + (size_t)(row0 + ai * HALF + m * 16) * 2816 + col0) = pack8(a[0], a[1]); }
    }
};


template <class Epi, class Sched, bool ALIGN_EPI = false, bool SP2 = false>
__device__ __forceinline__ void gemm_phase(PG8_LAS unsigned char* lds, const Gemm g, const Sched& S, const Epi& E) {
    int tid_ = threadIdx.x; asm volatile("" : "+v"(tid_));
    const int tid = tid_, wid = __builtin_amdgcn_readfirstlane(tid >> 6), lane = tid & 63, wr = wid >> 2, wc = wid & 3, fr = lane & 15, fq = lane >> 4;
    const int K = g.K, nt = K / BK;
    unsigned voffA[2], voffB[2];
#pragma unroll
    for (int i = 0; i < 2; ++i) { int R, C; stage_rc(tid * 16 + i * 8192, R, C); const int Rb = Epi::PERM ? ((R & ~31) + perm32(R & 31)) : R;
        voffA[i] = (unsigned)(R * K + C) * 2u; voffB[i] = (unsigned)(Rb * K + C) * 2u; }
    const size_t kstep = (size_t)(BK * 2);
    const size_t hstep = (size_t)HALF * K * 2;
    const size_t tstep = 2 * hstep;
    const unsigned ldsw = (unsigned)wid * 1024u;
    const int aoff = lds_byte(wr * 64 + fr, fq * 8), boff = lds_byte(wc * 32 + fr, fq * 8);
#define PG8_SA(b, h) (((b) * 2 + (h)) * HTB)
#define PG8_SB(b, h) ((4 + (b) * 2 + (h)) * HTB)
#define PG8_STAGE(bufoff, gbase, voff) do { _Pragma("unroll") for (int _i = 0; _i < 2; ++_i) \
        __builtin_amdgcn_global_load_lds((const unsigned*)((const char*)(gbase) + (voff)[_i]), (PG8_LAS unsigned*)(lds + (bufoff) + ldsw + _i * 8192), 16, 0, 0); } while (0)
#define PG8_LDA(dst, b, h) do { _Pragma("unroll") for (int m = 0; m < 4; ++m) _Pragma("unroll") for (int k = 0; k < 2; ++k) dst[m][k] = *(const PG8_LAS bf16x8*)(lds + PG8_SA(b, h) + aoff + m * 2048 + k * 1024); } while (0)
#define PG8_LDB(dst, b, h) do { _Pragma("unroll") for (int n = 0; n < 2; ++n) _Pragma("unroll") for (int k = 0; k < 2; ++k) dst[n][k] = *(const PG8_LAS bf16x8*)(lds + PG8_SB(b, h) + boff + n * 2048 + k * 1024); } while (0)
#define PG8_MMA(ai, bj, At, Bt) do { __builtin_amdgcn_s_setprio(1); _Pragma("unroll") for (int m = 0; m < 4; ++m) _Pragma("unroll") for (int n = 0; n < 2; ++n) _Pragma("unroll") for (int k = 0; k < 2; ++k) \
        acc[ai][bj][m][n] = __builtin_amdgcn_mfma_f32_16x16x32_bf16(Bt[n][k], At[m][k], acc[ai][bj][m][n], 0, 0, 0); __builtin_amdgcn_s_setprio(0); } while (0)
#define PG8_WAIT_V(n) asm volatile("s_waitcnt vmcnt(" #n ")" ::: "memory")
#define PG8_WAIT_L(n) asm volatile("s_waitcnt lgkmcnt(" #n ")" ::: "memory")
#define PG8_BAR __builtin_amdgcn_s_barrier()
#define PG8_SCHED __builtin_amdgcn_sched_barrier(0)
    Unit cur, nxt; int ui = 0;
    if (!S.next(0, cur)) return;
    f32x4 acc[2][2][4][2];
#pragma unroll
    for (int a = 0; a < 2; ++a)
#pragma unroll
        for (int b = 0; b < 2; ++b)
#pragma unroll
            for (int m = 0; m < 4; ++m)
#pragma unroll
                for (int n = 0; n < 2; ++n) acc[a][b][m][n] = (f32x4){0.f, 0.f, 0.f, 0.f};
    if constexpr (Epi::CINIT) E.cinit(acc, cur, wr, wc, fr, fq);
    bf16x8 At[4][2], B0[2][2], B1[2][2];
    const char* cA = (const char*)g.A + (size_t)cur.pm * tstep; const char* cB = (const char*)g.Bt + (size_t)cur.pn * tstep;
    S.a_ready(cur);
    if constexpr (SP2) {
        PG8_STAGE(PG8_SB(0, 0), cB, voffB); PG8_STAGE(PG8_SB(0, 1), cB + hstep, voffB); PG8_STAGE(PG8_SA(0, 0), cA, voffA); PG8_STAGE(PG8_SA(0, 1), cA + hstep, voffA);
        if (wr == 1) PG8_BAR;
        PG8_WAIT_V(2); PG8_BAR;
        PG8_STAGE(PG8_SB(1, 0), cB + kstep, voffB); PG8_STAGE(PG8_SA(1, 0), cA + kstep, voffA); PG8_STAGE(PG8_SB(1, 1), cB + hstep + kstep, voffB);
        PG8_WAIT_V(6); PG8_BAR;
    } else {
        PG8_STAGE(PG8_SB(0, 0), cB, voffB); PG8_STAGE(PG8_SA(0, 0), cA, voffA); PG8_STAGE(PG8_SB(0, 1), cB + hstep, voffB); PG8_STAGE(PG8_SA(0, 1), cA + hstep, voffA);
        if (wr == 1) PG8_BAR;
        PG8_WAIT_V(4); PG8_BAR;
        PG8_STAGE(PG8_SB(1, 0), cB + kstep, voffB); PG8_STAGE(PG8_SA(1, 0), cA + kstep, voffA); PG8_STAGE(PG8_SB(1, 1), cB + hstep + kstep, voffB);
        PG8_WAIT_V(6); PG8_BAR;
    }
    for (;;) {
        const bool has_next = S.next(ui + 1, nxt);
        const char* nA = has_next ? (const char*)g.A + (size_t)nxt.pm * tstep : cA; const char* nB = has_next ? (const char*)g.Bt + (size_t)nxt.pn * tstep : cB;
        for (int t = 0; t < nt; t += 2) {
            const bool last = (t == nt - 2);
            const char* a1 = cA + (size_t)(t + 1) * kstep;
            const char* a2 = last ? nA : cA + (size_t)(t + 2) * kstep; const char* b2 = last ? nB : cB + (size_t)(t + 2) * kstep;
            const char* a3 = a2 + kstep; const char* b3 = b2 + kstep;
            if (last && has_next) S.a_ready(nxt);
            if constexpr (SP2) {
            PG8_LDB(B0, 0, 0); PG8_LDB(B1, 0, 1); PG8_SCHED; PG8_LDA(At, 0, 0); PG8_STAGE(PG8_SA(1, 1), a1 + hstep, voffA);
            PG8_WAIT_V(8); PG8_WAIT_L(0); PG8_BAR; PG8_MMA(0, 0, At, B0); PG8_MMA(0, 1, At, B1); PG8_BAR; PG8_SCHED;
            PG8_LDA(At, 0, 1); PG8_STAGE(PG8_SB(0, 0), b2, voffB); PG8_STAGE(PG8_SB(0, 1), b2 + hstep, voffB); PG8_STAGE(PG8_SA(0, 0), a2, voffA);
            PG8_WAIT_V(8); PG8_WAIT_L(0); PG8_BAR; PG8_MMA(1, 0, At, B0); PG8_MMA(1, 1, At, B1); PG8_BAR; PG8_SCHED;
            PG8_LDB(B0, 1, 0); PG8_LDB(B1, 1, 1); PG8_SCHED; PG8_LDA(At, 1, 0); PG8_STAGE(PG8_SA(0, 1), a2 + hstep, voffA);
            PG8_WAIT_V(8); PG8_WAIT_L(0); PG8_BAR; PG8_MMA(0, 0, At, B0); PG8_MMA(0, 1, At, B1); PG8_BAR; PG8_SCHED;
            PG8_LDA(At, 1, 1); PG8_STAGE(PG8_SB(1, 0), b3, voffB); PG8_STAGE(PG8_SB(1, 1), b3 + hstep, voffB); PG8_STAGE(PG8_SA(1, 0), a3, voffA);
            PG8_WAIT_V(8); PG8_WAIT_L(0); PG8_BAR; PG8_MMA(1, 0, At, B0); PG8_MMA(1, 1, At, B1); PG8_BAR; PG8_SCHED;
            } else {
            PG8_LDB(B0, 0, 0); PG8_SCHED; PG8_LDA(At, 0, 0); PG8_STAGE(PG8_SA(1, 1), a1 + hstep, voffA);
            PG8_WAIT_L(8); PG8_BAR; PG8_WAIT_L(0); PG8_MMA(0, 0, At, B0); PG8_BAR; PG8_SCHED;
            PG8_LDB(B1, 0, 1); PG8_STAGE(PG8_SB(0, 0), b2, voffB);
            PG8_BAR; PG8_WAIT_L(0); PG8_MMA(0, 1, At, B1); PG8_BAR;
            PG8_LDA(At, 0, 1); PG8_STAGE(PG8_SA(0, 0), a2, voffA);
            PG8_BAR; PG8_WAIT_L(0); PG8_MMA(1, 0, At, B0); PG8_BAR; PG8_SCHED;
            PG8_STAGE(PG8_SB(0, 1), b2 + hstep, voffB);
            PG8_WAIT_V(6); PG8_BAR; PG8_MMA(1, 1, At, B1); PG8_BAR;
            PG8_LDB(B0, 1, 0); PG8_SCHED; PG8_LDA(At, 1, 0); PG8_STAGE(PG8_SA(0, 1), a2 + hstep, voffA);
            PG8_WAIT_L(8); PG8_BAR; PG8_WAIT_L(0); PG8_MMA(0, 0, At, B0); PG8_BAR; PG8_SCHED;
            PG8_LDB(B1, 1, 1); PG8_STAGE(PG8_SB(1, 0), b3, voffB);
            PG8_BAR; PG8_WAIT_L(0); PG8_MMA(0, 1, At, B1); PG8_BAR;
            PG8_LDA(At, 1, 1); PG8_STAGE(PG8_SA(1, 0), a3, voffA);
            PG8_BAR; PG8_WAIT_L(0); PG8_MMA(1, 0, At, B0); PG8_BAR; PG8_SCHED;
            PG8_STAGE(PG8_SB(1, 1), b3 + hstep, voffB);
            PG8_WAIT_V(6); PG8_BAR; PG8_MMA(1, 1, At, B1); PG8_BAR;
            }
        }
        if constexpr (ALIGN_EPI) { if (wr == 0) PG8_BAR; }
        if constexpr (!Epi::AFTER_DRAIN) { E(acc, cur, wr, wc, fr, fq); S.done(cur); }
        if (!has_next) break;
#pragma unroll
        for (int a = 0; a < 2; ++a)
#pragma unroll
            for (int b = 0; b < 2; ++b)
#pragma unroll
                for (int m = 0; m < 4; ++m)
#pragma unroll
                    for (int n = 0; n < 2; ++n) acc[a][b][m][n] = (f32x4){0.f, 0.f, 0.f, 0.f};
        cur = nxt; cA = nA; cB = nB; ++ui;
        if constexpr (Epi::CINIT) E.cinit(acc, cur, wr, wc, fr, fq);
        if constexpr (ALIGN_EPI) { if (wr == 1) PG8_BAR; }
    }
    PG8_WAIT_V(0);
    if constexpr (!ALIGN_EPI) { if (wr == 0) PG8_BAR; }
    PG8_BAR;
    if constexpr (Epi::AFTER_DRAIN) { E.fused(acc, cur, wr, wc, fr, fq, lds, wid, lane); S.done(cur); }
#undef PG8_SA
#undef PG8_SB
#undef PG8_STAGE
#undef PG8_LDA
#undef PG8_LDB
#undef PG8_MMA
#undef PG8_WAIT_V
#undef PG8_WAIT_L
#undef PG8_BAR
#undef PG8_SCHED
}
}

namespace attn_body {
using bf16=unsigned short;
using bf16x8=__attribute__((ext_vector_type(8)))short;
using s16x4=__attribute__((ext_vector_type(4)))short;
using f32x16=__attribute__((ext_vector_type(16)))float;
using f32x4=__attribute__((ext_vector_type(4)))float;
using u32x4=__attribute__((ext_vector_type(4)))unsigned;
constexpr int D=64;
constexpr int NW=8,QBLK=32,QB=QBLK*NW,KVBLK=64;
__device__ __forceinline__ int crow(int r,int hi){return (r&3)+8*(r>>2)+4*hi;}
#define SBAR() __builtin_amdgcn_sched_barrier(0)
__device__ __forceinline__ void cmask(f32x16&p0,f32x16&p1,int jb,int qrel,int hi){
  const float NEG=-INFINITY; int kb=64*jb+4*hi;
  #pragma unroll
  for(int r=0;r<16;++r){int kv=kb+(r&3)+8*(r>>2); if(kv>qrel)p0[r]=NEG; if(kv+32>qrel)p1[r]=NEG;}
}
constexpr int NSLOT=3, SLOTB=8192;
constexpr int LDS_K=0, LDS_V=NSLOT*SLOTB, LDS_WS=2*NSLOT*SLOTB, LDS_OST=LDS_WS+NW*64*4, LDS_BYTES=LDS_OST+NW*4096;
constexpr int GT_OFF=86016, SEL_OFF=GT_OFF+32768, KM_OFF=SEL_OFF+1024, RED_OFF=KM_OFF+8192, BASE_OFF=RED_OFF+128, CNTL_OFF=BASE_OFF+128, ATTN_LDS_END=CNTL_OFF+128, RES_GT_OFF=100352, ALLT_OFF=102400;
__device__ __forceinline__ void glds16(const void*gsrc,unsigned lds_dst){unsigned keep;
  asm volatile("s_mov_b32 %0, m0\n\ts_mov_b32 m0, %2\n\ts_nop 0\n\tglobal_load_lds_dwordx4 %1, off\n\ts_mov_b32 m0, %0":"=&s"(keep):"v"(gsrc),"s"(lds_dst):"memory");}
__device__ __forceinline__ float max3f(float a,float b,float c){float r;asm("v_max3_f32 %0, %1, %2, %3":"=v"(r):"v"(a),"v"(b),"v"(c));return r;}
__device__ __forceinline__ float max2f(float a,float b){float r;asm("v_max_f32_e32 %0, %1, %2":"=v"(r):"v"(a),"v"(b));return r;}
__device__ __forceinline__ float fadd_s(float a,float b){float r;asm("v_add_f32_e32 %0, %1, %2":"=v"(r):"v"(a),"v"(b));return r;}
__device__ __forceinline__ float fsub_s(float a,float b){float r;asm("v_sub_f32_e32 %0, %1, %2":"=v"(r):"v"(a),"v"(b));return r;}
typedef float f32x2_t __attribute__((ext_vector_type(2))); typedef __bf16 bf16x2_t __attribute__((ext_vector_type(2)));
__device__ __forceinline__ unsigned cvtpk_s(float lo,float hi){f32x2_t v={lo,hi};bf16x2_t b=__builtin_convertvector(v,bf16x2_t);return __builtin_bit_cast(unsigned,b);}
#define WAIT_BAR(N) asm volatile("s_waitcnt vmcnt(" #N ") lgkmcnt(0)\n\ts_barrier":::"memory")

__device__ __forceinline__ void qkt(f32x16&p0,f32x16&p1,const char*Kslot,const bf16x8*qr,int r32,int hi){
  const char*kb=Kslot+hi*1024+r32*16;
  #pragma unroll
  for(int d0=0;d0<4;++d0){
    const bf16x8 b0=*reinterpret_cast<const bf16x8*>(kb+d0*2048);
    const bf16x8 b1=*reinterpret_cast<const bf16x8*>(kb+d0*2048+512);
    p0=__builtin_amdgcn_mfma_f32_32x32x16_bf16(b0,qr[d0],p0,0,0,0);p1=__builtin_amdgcn_mfma_f32_32x32x16_bf16(b1,qr[d0],p1,0,0,0);}
}
typedef __attribute__((address_space(3))) const char* lds_cptr;
typedef short v4i16_t __attribute__((ext_vector_type(4)));
__device__ __forceinline__ void kload8(bf16x8*kf,lds_cptr kp){
  kf[0]=*(const __attribute__((address_space(3))) bf16x8*)(kp);      kf[1]=*(const __attribute__((address_space(3))) bf16x8*)(kp+512);
  kf[2]=*(const __attribute__((address_space(3))) bf16x8*)(kp+2048); kf[3]=*(const __attribute__((address_space(3))) bf16x8*)(kp+2560);
  kf[4]=*(const __attribute__((address_space(3))) bf16x8*)(kp+4096); kf[5]=*(const __attribute__((address_space(3))) bf16x8*)(kp+4608);
  kf[6]=*(const __attribute__((address_space(3))) bf16x8*)(kp+6144); kf[7]=*(const __attribute__((address_space(3))) bf16x8*)(kp+6656);
}
__device__ __forceinline__ void kload2(bf16x8*kf,lds_cptr kp,int j){ kf[2*j]=*(const __attribute__((address_space(3))) bf16x8*)(kp+j*2048); kf[2*j+1]=*(const __attribute__((address_space(3))) bf16x8*)(kp+j*2048+512); }
__device__ __forceinline__ s16x4 vtr(lds_cptr p){ return __builtin_bit_cast(s16x4,__builtin_amdgcn_ds_read_tr16_b64_v4i16((__attribute__((address_space(3))) v4i16_t*)p)); }
__device__ __forceinline__ float rowmax(const f32x16&p0,const f32x16&p1){
  float a=max3f(p0[0],p0[1],p1[0]),b=max3f(p0[2],p0[3],p1[1]);a=max3f(a,p1[2],p1[3]);
  #pragma unroll
  for(int r=4;r<16;r+=4){a=max3f(a,p0[r],p0[r+1]);b=max3f(b,p0[r+2],p0[r+3]);a=max3f(a,p1[r],p1[r+1]);b=max3f(b,p1[r+2],p1[r+3]);}
  const float m=max2f(a,b);
  auto rr=__builtin_amdgcn_permlane32_swap(__float_as_uint(m),__float_as_uint(m),false,false);
  return max2f(__uint_as_float(rr[0]),__uint_as_float(rr[1]));
}
__device__ __forceinline__ void pv(f32x16*o,int vb,bf16x8 pa0,bf16x8 pa1,bf16x8 pa2,bf16x8 pa3){
  #pragma unroll
  for(int d0=0;d0<2;++d0){s16x4 lo[4],hi[4];
    #pragma unroll
    for(int ks=0;ks<4;++ks){
      asm volatile("ds_read_b64_tr_b16 %0,%1 offset:%c2":"=&v"(lo[ks]):"v"(vb),"i"(d0*4096+ks*1024):"memory");
      asm volatile("ds_read_b64_tr_b16 %0,%1 offset:%c2":"=&v"(hi[ks]):"v"(vb),"i"(d0*4096+ks*1024+512):"memory");}
    asm volatile("s_waitcnt lgkmcnt(0)":::"memory");SBAR();
    #define PK(k) (bf16x8){lo[k][0],lo[k][1],lo[k][2],lo[k][3],hi[k][0],hi[k][1],hi[k][2],hi[k][3]}
    o[d0]=__builtin_amdgcn_mfma_f32_32x32x16_bf16(pa0,PK(0),o[d0],0,0,0);
    o[d0]=__builtin_amdgcn_mfma_f32_32x32x16_bf16(pa1,PK(1),o[d0],0,0,0);
    o[d0]=__builtin_amdgcn_mfma_f32_32x32x16_bf16(pa2,PK(2),o[d0],0,0,0);
    o[d0]=__builtin_amdgcn_mfma_f32_32x32x16_bf16(pa3,PK(3),o[d0],0,0,0);
    #undef PK
  }
}
#ifndef ATTN_STORE16
#define ATTN_STORE16(p,v) (*(u32x4*)(p)=(v))
#endif
typedef __attribute__((address_space(3))) const float* lds_fptr;
struct AttnAux { const unsigned* list; float* ml; const unsigned* ent; const bf16* part; const float* mlr; float sl2; int nvalid; int base_off; int pad; };
template<int MODE,int THRL,bool RES=false,bool ST=false> __device__ __forceinline__ void attn_unit(const bf16*Qw0,int QP,const bf16*__restrict__ Kh,const bf16*__restrict__ Vh,int KVP,bf16*Ow0,int OP,int NTF,int T0,char*shm,const AttnAux&aux=AttnAux{},float m0=0.f){
  int tid_=threadIdx.x; asm volatile("":"+v"(tid_));
  const int tid=tid_,lane=tid&63,r32=lane&31,hi=lane>>5; const int wid=__builtin_amdgcn_readfirstlane(tid>>6);
  const bf16*Qw=Qw0+(long)(wid*QBLK)*QP;
  const int NT=NTF-T0;
  constexpr int NSL=RES?4:NSLOT, L_K=0, L_V=NSL*SLOTB, L_WS=RES?65536:LDS_WS, L_OST=RES?67584:LDS_OST, L_GT=RES?RES_GT_OFF:GT_OFF;
  const unsigned lds0=(unsigned)(uintptr_t)shm;
  float*wsf=(float*)(shm+L_WS)+wid*64;
  const bf16*ksrc=Kh+(long)lane*KVP+wid*8;
  const bf16*vsrc=Vh+(long)(16*(wid&3)+(lane>>2))*KVP+(wid>>2)*32+(lane&3)*8;
  const unsigned kdst=lds0+L_K+wid*1024, vdst=lds0+L_V+wid*1024;
  #define TILE(s) (RES ? (s) : MODE==1 ? ((s)==0 ? NTF-4 : ((s)<=NT-4 ? T0+(s)-1 : T0+(s))) : T0+(s))
  #define BANDJ(s) ((MODE==0||MODE==4) ? (s)-(NT-4) : (MODE==1 ? ((s)==0 ? 0 : ((s)>NT-4 ? (s)-(NT-4) : -1)) : -1))
  #define DMA_K(t,slot) do{ if(!RES) glds16(ksrc+(long)TILE(t)*KVBLK*KVP,(unsigned)__builtin_amdgcn_readfirstlane(kdst+(slot))); }while(0)
  #define DMA_V(t,slot) do{ if(!RES) glds16(vsrc+(long)TILE(t)*KVBLK*KVP,(unsigned)__builtin_amdgcn_readfirstlane(vdst+(slot))); }while(0)
  #define WB(N) do{ if(RES){ asm volatile("s_waitcnt lgkmcnt(0)":::"memory"); } else { WAIT_BAR(N); } }while(0)
  const int vb0=(int)(lds0+L_V)+((lane>>4)&1)*32+(lane&3)*8+(4*hi+((lane&15)>>2))*64;
  const char*Kbase=shm+L_K; bf16x8 kf[8];
  const lds_cptr shm3=(lds_cptr)shm; const lds_cptr kp0=shm3+L_K+hi*1024+r32*16; const lds_cptr vp0=shm3+L_V+((lane>>4)&1)*32+(lane&3)*8+(4*hi+((lane&15)>>2))*64;
  const lds_fptr gp0=(lds_fptr)(shm3+L_GT)+4*hi;
  DMA_K(0,0);DMA_V(0,0);DMA_K(1,SLOTB);
  bf16x8 qr[4];
  u32x4 enp[4]; if constexpr(MODE==4){ _Pragma("unroll") for(int i=0;i<4;++i) enp[i]=*(const u32x4*)(aux.ent+(size_t)(wid*QBLK+i*8+(lane>>3))*4); }
  int tq=0;
  if(MODE==3){ const int e_=RES?r32:wid*QBLK+r32; tq=(int)aux.list[e_<aux.nvalid?e_:0]; }
  { const bf16*qrow=(MODE==3)?(Qw0+(long)tq*QP):(Qw+(long)r32*QP);
  #pragma unroll
  for(int d0=0;d0<4;++d0)qr[d0]=*reinterpret_cast<const bf16x8*>(&qrow[d0*16+hi*8]); }
  float mhat=ST?m0:0.f,l_reg=0.f;f32x16 o[2];o[0]=f32x16{};o[1]=f32x16{};
  const int qrel=wid*QBLK+r32;
  float gt=0.f; unsigned selbits=0xffffffffu;
  if(MODE==3) gt=-aux.sl2*(float)tq; else if(MODE!=2) gt=((lds_fptr)(shm3+L_GT))[64*(NTF-4)+qrel];
  if(MODE==1) selbits=((const __attribute__((address_space(3))) unsigned*)(shm3+SEL_OFF))[qrel];
  #define CI_LOAD(X0,X1,stp) do{ if(MODE!=2){ const lds_fptr gp_=gp0+64*TILE(stp); \
      _Pragma("unroll") for(int g_=0;g_<4;++g_){ const f32x4 a_=*(const __attribute__((address_space(3))) f32x4*)(gp_+8*g_); const f32x4 b_=*(const __attribute__((address_space(3))) f32x4*)(gp_+32+8*g_); \
        X0[4*g_]=a_[0];X0[4*g_+1]=a_[1];X0[4*g_+2]=a_[2];X0[4*g_+3]=a_[3]; X1[4*g_]=b_[0];X1[4*g_+1]=b_[1];X1[4*g_+2]=b_[2];X1[4*g_+3]=b_[3]; } } }while(0)
  #define CI_LOAD0(X0,stp) do{ if(MODE!=2){ const lds_fptr gp_=gp0+64*TILE(stp); \
      _Pragma("unroll") for(int g_=0;g_<4;++g_){ const f32x4 a_=*(const __attribute__((address_space(3))) f32x4*)(gp_+8*g_); X0[4*g_]=a_[0];X0[4*g_+1]=a_[1];X0[4*g_+2]=a_[2];X0[4*g_+3]=a_[3]; } } }while(0)
  #define CI_LOAD1(X1,stp) do{ if(MODE!=2){ const lds_fptr gp_=gp0+64*TILE(stp); \
      _Pragma("unroll") for(int g_=0;g_<4;++g_){ const f32x4 b_=*(const __attribute__((address_space(3))) f32x4*)(gp_+32+8*g_); X1[4*g_]=b_[0];X1[4*g_+1]=b_[1];X1[4*g_+2]=b_[2];X1[4*g_+3]=b_[3]; } } }while(0)
  #define CB(stp) ((MODE==1 && !((selbits>>(TILE(stp)>>2))&1u)) ? -INFINITY : (gt-mhat))
  #define CI_SUB4(X,B,cb) do{ if(MODE!=2){ X[B]=fsub_s((cb),X[B]); X[B+1]=fsub_s((cb),X[B+1]); X[B+2]=fsub_s((cb),X[B+2]); X[B+3]=fsub_s((cb),X[B+3]); }     else { X[B]=(cb); X[B+1]=(cb); X[B+2]=(cb); X[B+3]=(cb); } }while(0)
  #define CMASK(P0,P1,t) do{int jb_=BANDJ(t); if(jb_>=0)cmask(P0,P1,jb_,qrel,hi);}while(0)
  bool resc=false;
  #define START(P0,P1) do{ resc=false; \
    if constexpr(!ST){ const float rm=rowmax(P0,P1); const float dl=rm; mhat=fadd_s(mhat,dl); \
      _Pragma("unroll") for(int r=0;r<16;++r){P0[r]=fsub_s(P0[r],dl);P1[r]=fsub_s(P1[r],dl);} } \
    _Pragma("unroll") for(int r=0;r<16;++r)P0[r]=__builtin_amdgcn_exp2f(P0[r]); }while(0)
  #define RESC() do{ if(resc){ asm volatile("s_waitcnt lgkmcnt(0)":::"memory"); \
      _Pragma("unroll") for(int d_=0;d_<2;++d_) _Pragma("unroll") for(int r=0;r<16;++r)o[d_][r]*=wsf[crow(r,hi)]; } }while(0)
  f32x16 pA0,pA1,pB0,pB1;
  int sl_prev=0,sl_cur=0,sl_next=SLOTB;
  #define ROT() do{sl_prev=sl_cur;sl_cur=sl_next;sl_next=(sl_next==(NSL-1)*SLOTB)?0:sl_next+SLOTB;}while(0)
  DMA_K(2,2*SLOTB);
  { CI_LOAD(pA0,pA1,0); const float cb0=CB(0);
    CI_SUB4(pA0,0,cb0);CI_SUB4(pA0,4,cb0);CI_SUB4(pA0,8,cb0);CI_SUB4(pA0,12,cb0);CI_SUB4(pA1,0,cb0);CI_SUB4(pA1,4,cb0);CI_SUB4(pA1,8,cb0);CI_SUB4(pA1,12,cb0); }
  WB(3);
  qkt(pA0,pA1,Kbase,qr,r32,hi);asm volatile("s_nop 15\n\ts_nop 7":"+v"(pA0),"+v"(pA1));CMASK(pA0,pA1,0);
  START(pA0,pA1);
  _Pragma("unroll") for(int r=0;r<16;++r)pA1[r]=__builtin_amdgcn_exp2f(pA1[r]);
  { CI_LOAD(pB0,pB1,1); const float cb1=CB(1);
    CI_SUB4(pB0,0,cb1);CI_SUB4(pB0,4,cb1);CI_SUB4(pB0,8,cb1);CI_SUB4(pB0,12,cb1);CI_SUB4(pB1,0,cb1);CI_SUB4(pB1,4,cb1);CI_SUB4(pB1,8,cb1);CI_SUB4(pB1,12,cb1); }
  WB(0);
  DMA_K(3,0);DMA_V(1,SLOTB);
  ROT();
  kload8(kf,kp0+sl_cur);
  WB(2);
  s16x4 vlo[8],vhi[8]; u32x4 pw0,pw1,pw2,pw3;
  #define PKW(P,B) cvtpk_s(P[B],P[B+1])
  #define PAF(k) __builtin_bit_cast(bf16x8,pw##k)
  #define VFR(i) (bf16x8){vlo[i][0],vlo[i][1],vlo[i][2],vlo[i][3],vhi[i][0],vhi[i][1],vhi[i][2],vhi[i][3]}
  #define PIN(x) asm volatile("":"+v"(x))
  #define MX3(a,b,c) __builtin_fmaxf(__builtin_fmaxf((a),(b)),(c))
  #define GAPA(MF,CX,A0,A1,A2,A3,W0,W1,PW) do{ MF; sacc+=A0; sacb+=A1; sacc+=A2; sacb+=A3; PIN(sacc); PIN(sacb); W0; W1; PIN(PW); PIN(CX); SBAR(); }while(0)
  #define EX(v) __builtin_amdgcn_exp2f(v)
  #define GAPB(MF,X,B,PN,PB,GN) do{ MF; X[B]=EX(X[B]); X[B+1]=EX(X[B+1]); X[B+2]=EX(X[B+2]); X[B+3]=EX(X[B+3]); PIN(X); if(GN){ CI_SUB4(PN,PB,cbn); PIN(PN); } SBAR(); }while(0)
  #define VRD(i) do{ vlo[i]=vtr(vp_+(((i)>>2)*4096+((i)&3)*1024)); vhi[i]=vtr(vp_+(((i)>>2)*4096+((i)&3)*1024+512)); }while(0)
  #define KRD(G,j) do{ if(G){ kload2(kf,kp0+sl_next,j); SBAR(); } }while(0)
  #define STEP(C0,C1,P0,P1,t,GK,GV,GL,GN) do{ SBAR(); \
    const lds_cptr vp_=vp0+sl_prev; \
    VRD(0); SBAR(); float sacc=P0[0],sacb=P0[1]; \
    GAPA(C0=__builtin_amdgcn_mfma_f32_32x32x16_bf16(kf[0],qr[0],C0,0,0,0), C0, P0[2],P0[3],P0[4],P0[5],     pw0[0]=PKW(P0,0), pw0[1]=PKW(P0,2), pw0); \
    VRD(4); SBAR(); GAPA(C1=__builtin_amdgcn_mfma_f32_32x32x16_bf16(kf[1],qr[0],C1,0,0,0), C1, P0[6],P0[7],P0[8],P0[9],     pw0[2]=PKW(P0,4), pw0[3]=PKW(P0,6), pw0); \
    VRD(1); SBAR(); GAPA(C0=__builtin_amdgcn_mfma_f32_32x32x16_bf16(kf[2],qr[1],C0,0,0,0), C0,   P0[10],P0[11],P0[12],P0[13], pw1[0]=PKW(P0,8), pw1[1]=PKW(P0,10), pw1); \
    VRD(5); SBAR(); GAPA(C1=__builtin_amdgcn_mfma_f32_32x32x16_bf16(kf[3],qr[1],C1,0,0,0), C1,   P0[14],P0[15],P1[0],P1[1],   pw1[2]=PKW(P0,12),pw1[3]=PKW(P0,14), pw1); \
    if(GN){ CI_LOAD0(P0,(t)+1); SBAR(); }     \
    VRD(2); SBAR(); GAPA(C0=__builtin_amdgcn_mfma_f32_32x32x16_bf16(kf[4],qr[2],C0,0,0,0), C0,   P1[2],P1[3],P1[4],P1[5],     pw2[0]=PKW(P1,0), pw2[1]=PKW(P1,2), pw2); \
    VRD(6); SBAR(); GAPA(C1=__builtin_amdgcn_mfma_f32_32x32x16_bf16(kf[5],qr[2],C1,0,0,0), C1,   P1[6],P1[7],P1[8],P1[9],     pw2[2]=PKW(P1,4), pw2[3]=PKW(P1,6), pw2); \
    VRD(3); SBAR(); GAPA(C0=__builtin_amdgcn_mfma_f32_32x32x16_bf16(kf[6],qr[3],C0,0,0,0), C0,   P1[10],P1[11],P1[12],P1[13], pw3[0]=PKW(P1,8), pw3[1]=PKW(P1,10), pw3); \
    VRD(7); SBAR(); GAPA(C1=__builtin_amdgcn_mfma_f32_32x32x16_bf16(kf[7],qr[3],C1,0,0,0), C1,   P1[14],P1[15],0.f,0.f,       pw3[2]=PKW(P1,12),pw3[3]=PKW(P1,14), pw3); \
    l_reg+=sacc+sacb; \
    if(GN){ CI_LOAD1(P1,(t)+1); } \
    CMASK(C0,C1,t); \
    if constexpr(!ST){ float a=MX3(C0[0],C0[1],C1[0]),b=MX3(C0[2],C0[3],C1[1]); a=MX3(a,C1[2],C1[3]); \
      _Pragma("unroll") for(int r=4;r<16;r+=4){a=MX3(a,C0[r],C0[r+1]);b=MX3(b,C0[r+2],C0[r+3]);a=MX3(a,C1[r],C1[r+1]);b=MX3(b,C1[r+2],C1[r+3]);} \
      float rm=__builtin_fmaxf(a,b); { auto rr=__builtin_amdgcn_permlane32_swap(__float_as_uint(rm),__float_as_uint(rm),false,false); rm=__builtin_fmaxf(__uint_as_float(rr[0]),__uint_as_float(rr[1])); } \
      resc=false; \
      if(__builtin_expect(__any(rm>(float)THRL),0)){ const float dl=(rm>(float)THRL)?rm:0.f; mhat+=dl;     \
        _Pragma("unroll") for(int r=0;r<16;++r){C0[r]-=dl;C1[r]-=dl;} \
        const float f=__builtin_amdgcn_exp2f(-dl); l_reg*=f; if(hi==0)wsf[r32]=f; resc=true; } } \
    float cbn=0.f; if(GN){ cbn=CB((t)+1); } \
    SBAR(); \
    GAPB(o[0]=__builtin_amdgcn_mfma_f32_32x32x16_bf16(PAF(0),VFR(0),o[0],0,0,0), C0,0, P0,0,GN); \
    GAPB(o[1]=__builtin_amdgcn_mfma_f32_32x32x16_bf16(PAF(0),VFR(4),o[1],0,0,0), C0,4, P0,4,GN); \
    if(GK){DMA_K((t)+3,sl_cur); SBAR();}     \
    KRD(GL,0); GAPB(o[0]=__builtin_amdgcn_mfma_f32_32x32x16_bf16(PAF(1),VFR(1),o[0],0,0,0), C0,8, P0,8,GN); \
    KRD(GL,1); GAPB(o[1]=__builtin_amdgcn_mfma_f32_32x32x16_bf16(PAF(1),VFR(5),o[1],0,0,0), C0,12, P0,12,GN); \
    KRD(GL,2); GAPB(o[0]=__builtin_amdgcn_mfma_f32_32x32x16_bf16(PAF(2),VFR(2),o[0],0,0,0), C1,0, P1,0,GN); \
    KRD(GL,3); GAPB(o[1]=__builtin_amdgcn_mfma_f32_32x32x16_bf16(PAF(2),VFR(6),o[1],0,0,0), C1,4, P1,4,GN); \
    if(GV){DMA_V((t)+1,sl_next); SBAR();} \
    GAPB(o[0]=__builtin_amdgcn_mfma_f32_32x32x16_bf16(PAF(3),VFR(3),o[0],0,0,0), C1,8, P1,8,GN); \
    GAPB(o[1]=__builtin_amdgcn_mfma_f32_32x32x16_bf16(PAF(3),VFR(7),o[1],0,0,0), C1,12, P1,12,GN); \
    }while(0)
  int t=1;
  #undef CMASK
  #define CMASK(P0,P1,t) do{}while(0)
  for(;t+5<NT;t+=2){
    STEP(pB0,pB1,pA0,pA1,t,true,true,true,true);     WB(2); RESC(); ROT();
    STEP(pA0,pA1,pB0,pB1,t+1,true,true,true,true);   WB(2); RESC(); ROT();
  }
  #undef CMASK
  #define CMASK(P0,P1,t) do{int jb_=BANDJ(t); if(jb_>=0)cmask(P0,P1,jb_,qrel,hi);}while(0)
  #define ENDW(tt) do{ if((tt)+3<NT){WB(2);} else if((tt)+2<NT){WB(1);} else {WB(0);} }while(0)
  #define TAIL(P0,P1,VS) do{ float sacc=P0[0]+P0[1]; _Pragma("unroll") for(int r=2;r<16;++r)sacc+=P0[r]; _Pragma("unroll") for(int r=0;r<16;++r)sacc+=P1[r]; l_reg+=sacc; \
    pw0=(u32x4){PKW(P0,0),PKW(P0,2),PKW(P0,4),PKW(P0,6)};pw1=(u32x4){PKW(P0,8),PKW(P0,10),PKW(P0,12),PKW(P0,14)};pw2=(u32x4){PKW(P1,0),PKW(P1,2),PKW(P1,4),PKW(P1,6)};pw3=(u32x4){PKW(P1,8),PKW(P1,10),PKW(P1,12),PKW(P1,14)}; \
    SBAR(); pv(o,vb0+(VS),PAF(0),PAF(1),PAF(2),PAF(3)); }while(0)
  if constexpr(MODE==4&&RES){
    const int ntw=(wid>>1)+1;
    if(ntw>1){ STEP(pB0,pB1,pA0,pA1,1,false,true,true,true); WB(1); RESC(); }
    if(ntw>2){ ROT(); STEP(pA0,pA1,pB0,pB1,2,false,true,true,true); WB(0); RESC(); }
    if(ntw>3){ ROT(); STEP(pB0,pB1,pA0,pA1,3,false,false,false,false); RESC(); }
    if(ntw&1){ pB0=pA0; pB1=pA1; }
    const int vs_=(ntw==1)?sl_prev:sl_cur;
    TAIL(pB0,pB1,vs_);
  } else if constexpr(MODE==0){
  #define LIGHT(tt,GK,GV) do{ resc=false; if(GK){DMA_K((tt)+3,sl_cur);} if(GV){DMA_V((tt)+1,sl_next);} }while(0)
  if(t+3<NT){
    STEP(pB0,pB1,pA0,pA1,t,true,true,true,true);      WB(2); RESC(); ROT();
    STEP(pA0,pA1,pB0,pB1,t+1,true,true,true,true);    WB(2); RESC(); ROT();
    t+=2; }
  STEP(pB0,pB1,pA0,pA1,t,false,true,true,true);       WB(1); RESC(); ROT();
  if(wid>=2){ STEP(pA0,pA1,pB0,pB1,t+1,false,true,true,true); } else { LIGHT(t+1,false,true); }
  WB(0); RESC(); ROT();
  if(wid>=4){ STEP(pB0,pB1,pA0,pA1,t+2,false,false,false,false); RESC(); }
  if(wid>=6){ TAIL(pB0,pB1,sl_cur); }
  #undef LIGHT
  } else {
  for(;t+1<NT;t+=2){
    STEP(pB0,pB1,pA0,pA1,t,(t+3<NT),(t+1<NT),(t+1<NT),(t+1<NT));       ENDW(t);   RESC(); ROT();
    STEP(pA0,pA1,pB0,pB1,t+1,(t+4<NT),(t+2<NT),(t+2<NT),(t+2<NT));     ENDW(t+1); RESC(); ROT();
  }
  STEP(pB0,pB1,pA0,pA1,NT-1,false,false,false,false); RESC();
  TAIL(pB0,pB1,sl_cur);
  }
  #undef TAIL
  #undef PKW
  #undef PAF
  #undef VFR
  #undef PIN
  #undef MX3
  #undef GAPA
  #undef GAPB
  #undef EX
  #undef VRD
  #undef KRD
  #undef STEP
  #undef ENDW
  {auto rr=__builtin_amdgcn_permlane32_swap(__float_as_uint(l_reg),__float_as_uint(l_reg),false,false);l_reg=__uint_as_float(rr[0])+__uint_as_float(rr[1]);}
  if(hi==0){wsf[32+r32]=l_reg; if(MODE==4)wsf[r32]=mhat;} asm volatile("s_waitcnt lgkmcnt(0)":::"memory");
  float rli[16];
  #pragma unroll
  for(int r=0;r<16;++r){ const float lv_=wsf[32+crow(r,hi)]; rli[r]=(ST&&MODE==3&&!(lv_>0.f))?0.f:__builtin_amdgcn_rcpf(lv_); }
  bf16*Ow=(RES&&MODE==3)?Ow0:Ow0+(long)(wid*QBLK)*OP;
  if(MODE==3){ const int e_=RES?r32:wid*QBLK+r32; if(hi==0&&e_<aux.nvalid){ f32x2_t v_={mhat,l_reg}; *(f32x2_t*)(aux.ml+2*e_)=v_; } }
  { bf16*stg=(bf16*)(shm+L_OST)+wid*2048;
    #pragma unroll
    for(int r=0;r<16;++r){const int orow=crow(r,hi);
      #pragma unroll
      for(int d0=0;d0<2;++d0)stg[orow*64+d0*32+r32]=(bf16)(cvtpk_s(o[d0][r]*rli[r],0.f)&0xffffu);}
    asm volatile("s_waitcnt lgkmcnt(0)":::"memory");
    if(MODE==4){
      const lds_fptr basej=(lds_fptr)(shm3+aux.base_off);
      #pragma unroll
      for(int i=0;i<4;++i){const int row=i*8+(lane>>3),ch=lane&7; const u32x4 v=*(const u32x4*)(stg+row*64+ch*8);
        const float m0=wsf[row], l0=wsf[32+row];
        const u32x4 en=enp[i];
        float mk[3],lk[3]; u32x4 pk[3]; float M=m0;
        #pragma unroll
        for(int k=0;k<3;++k){ mk[k]=-INFINITY; lk[k]=0.f; pk[k]=(u32x4){0u,0u,0u,0u};
          if((unsigned)k<en[3]){ const unsigned e_=__float_as_uint(basej[en[k]>>16])+(en[k]&0xffffu); const f32x2_t ml_=*(const f32x2_t*)(aux.mlr+2*(size_t)e_); mk[k]=ml_[0]; lk[k]=ml_[1];
            pk[k]=*(const u32x4*)(aux.part+(size_t)e_*64+ch*8); M=fmaxf(M,mk[k]); } }
        const float w0=l0*__builtin_amdgcn_exp2f(m0-M); float wk[3],den=w0;
        #pragma unroll
        for(int k=0;k<3;++k){ wk[k]=lk[k]*__builtin_amdgcn_exp2f(mk[k]-M); den+=wk[k]; }
        const float rd=__builtin_amdgcn_rcpf(den); u32x4 ov;
        #pragma unroll
        for(int c=0;c<4;++c){ float a0=w0*__uint_as_float(v[c]<<16), a1=w0*__uint_as_float(v[c]&0xffff0000u);
          #pragma unroll
          for(int k=0;k<3;++k){ a0+=wk[k]*__uint_as_float(pk[k][c]<<16); a1+=wk[k]*__uint_as_float(pk[k][c]&0xffff0000u); }
          ov[c]=cvtpk_s(a0*rd,a1*rd); }
        ATTN_STORE16(Ow+(long)row*OP+ch*8,ov);}
    } else {
    #pragma unroll
    for(int i=0;i<4;++i){const int row=i*8+(lane>>3),ch=lane&7; const u32x4 v=*(const u32x4*)(stg+row*64+ch*8); if(MODE!=3||(RES?row:wid*QBLK+row)<aux.nvalid) ATTN_STORE16(Ow+(long)row*OP+ch*8,v);} } }
  if(RES) asm volatile("s_waitcnt lgkmcnt(0)":::"memory"); else asm volatile("s_waitcnt lgkmcnt(0)\n\ts_barrier":::"memory");
  #undef WB
  #undef DMA_K
  #undef DMA_V
  #undef CMASK
  #undef START
  #undef RESC
  #undef ROT
  #undef TILE
  #undef BANDJ
  #undef CI_LOAD
  #undef CI_LOAD0
  #undef CI_LOAD1
  #undef CB
  #undef CI_SUB4
}
constexpr int ATTN_LDS_BYTES=LDS_BYTES;

__device__ __forceinline__ int tile_start(const char*shm,int NTF,float thr){
  int tid_=threadIdx.x; asm volatile("":"+v"(tid_)); const int lane=tid_&63; const lds_fptr gt=(lds_fptr)((lds_cptr)shm+GT_OFF);
  const float g0=gt[64*(NTF-4)];
  const int t1=lane, t2=lane+64;
  const bool ok1=(t1<NTF)&&(g0-gt[64*(t1<NTF?t1:0)+63]>=-thr), ok2=(t2<NTF)&&(g0-gt[64*(t2<NTF?t2:0)+63]>=-thr);
  const unsigned long long m1=__ballot(ok1), m2=__ballot(ok2);
  int ts = m1 ? (int)__builtin_ctzll(m1) : (m2 ? 64+(int)__builtin_ctzll(m2) : NTF-4);
  ts&=~1; if(ts>NTF-4)ts=NTF-4;
  return __builtin_amdgcn_readfirstlane(ts);
}
__device__ __forceinline__ float skip_thr(float maxq2,float maxk2){ return 150.0f+2.0f*(1.02f*sqrtf(maxq2*maxk2)+1.0f); }
__device__ __forceinline__ float skip_eff(float thr){ return thr<210.0f ? 128.0f : thr; }
typedef __attribute__((address_space(3))) float* lds_fwptr;
__device__ __forceinline__ float thr_from_nmax(const float*nm){ const f32x4 v=*(const f32x4*)nm; return skip_thr(v[0]+v[1],v[2]+v[3]); }
__device__ __forceinline__ void build_gtab_fox(const float*LFrow,char*shm){
  int tid_=threadIdx.x; asm volatile("":"+v"(tid_)); const int tid=tid_,lane=tid&63,wid=tid>>6;
  lds_fwptr gt=(lds_fwptr)(shm+GT_OFF); lds_fwptr red=(lds_fwptr)(shm+RED_OFF);
  float v[16];
  #pragma unroll
  for(int j=0;j<4;++j){const f32x4 x=*(const f32x4*)(LFrow+tid*16+4*j); v[4*j]=x[0];v[4*j+1]=x[1];v[4*j+2]=x[2];v[4*j+3]=x[3];}
  #pragma unroll
  for(int j=1;j<16;++j)v[j]+=v[j-1];
  const float tot=v[15]; float inc=tot;
  #pragma unroll
  for(int o=1;o<64;o<<=1){const float n=__shfl_up(inc,o); if(lane>=o)inc+=n;}
  if(lane==63)red[wid]=inc;
  __syncthreads();
  float woff=0.f;
  #pragma unroll
  for(int w=0;w<8;++w){ const float x=red[w]; if(w<wid)woff+=x; }
  const float off=woff+(inc-tot);
  #pragma unroll
  for(int j=0;j<4;++j){ f32x4 x; x[0]=v[4*j]+off;x[1]=v[4*j+1]+off;x[2]=v[4*j+2]+off;x[3]=v[4*j+3]+off; *(__attribute__((address_space(3))) f32x4*)(gt+tid*16+4*j)=x; }
  __syncthreads();
}
__device__ __forceinline__ void build_tabs_moba(float sl2,const float*kmean_bh  ,char*shm){
  int tid_=threadIdx.x; asm volatile("":"+v"(tid_)); const int tid=tid_;
  lds_fwptr gt=(lds_fwptr)(shm+GT_OFF); lds_fwptr km=(lds_fwptr)(shm+KM_OFF);
  #pragma unroll
  for(int j=0;j<4;++j){ f32x4 x; const int s=tid*16+4*j; x[0]=-sl2*(float)s;x[1]=-sl2*(float)(s+1);x[2]=-sl2*(float)(s+2);x[3]=-sl2*(float)(s+3); *(__attribute__((address_space(3))) f32x4*)(gt+s)=x; }
  { const int blk=tid>>4, c=(tid&15)*4; const f32x4 x=*(const f32x4*)(kmean_bh+(size_t)blk*768+c); *(__attribute__((address_space(3))) f32x4*)(km+blk*64+c)=x; }
  __syncthreads();
}
__device__ __forceinline__ void moba_route(const bf16*Qw0,int QP,int qb,char*shm){
  int tid_=threadIdx.x; asm volatile("":"+v"(tid_)); const int tid=tid_,row=tid>>1,half=tid&1;
  const lds_fptr km=(lds_fptr)(shm+KM_OFF)+half*32;
  float q[32];
  #pragma unroll
  for(int j=0;j<4;++j){ const u32x4 x=*(const u32x4*)(Qw0+(long)row*QP+half*32+8*j);
    #pragma unroll
    for(int k=0;k<4;++k){ q[8*j+2*k]=__uint_as_float(x[k]<<16); q[8*j+2*k+1]=__uint_as_float(x[k]&0xffff0000u); } }
  float g0=-INFINITY,g1=-INFINITY,g2=-INFINITY; int i0=-1,i1=-1,i2=-1;
  for(int n=0;n<qb;++n){
    float d=0.f;
    #pragma unroll
    for(int j=0;j<8;++j){ const f32x4 k4=*(const __attribute__((address_space(3))) f32x4*)(km+n*64+4*j); d+=q[4*j]*k4[0]; d+=q[4*j+1]*k4[1]; d+=q[4*j+2]*k4[2]; d+=q[4*j+3]*k4[3]; }
    d+=__shfl_xor(d,1);
    if(d>g0){g2=g1;i2=i1;g1=g0;i1=i0;g0=d;i0=n;} else if(d>g1){g2=g1;i2=i1;g1=d;i1=n;} else if(d>g2){g2=d;i2=n;}
  }
  unsigned bits=1u<<qb; if(i0>=0)bits|=1u<<i0; if(i1>=0)bits|=1u<<i1; if(i2>=0)bits|=1u<<i2;
  if(half==0)((__attribute__((address_space(3))) unsigned*)(shm+SEL_OFF))[row]=bits;
  __syncthreads();
}
__device__ __forceinline__ void load_block_kv(const bf16*Kh,const bf16*Vh,int KVP,int blk,float sl2,char*shm){
  int tid_=threadIdx.x; asm volatile("":"+v"(tid_)); const int tid=tid_,lane=tid&63; const int wid=__builtin_amdgcn_readfirstlane(tid>>6);
  const unsigned lds0=(unsigned)(uintptr_t)shm;
  const bf16*ksrc=Kh+(long)(256*blk+lane)*KVP+wid*8;
  const bf16*vsrc=Vh+(long)(256*blk+16*(wid&3)+(lane>>2))*KVP+(wid>>2)*32+(lane&3)*8;
  #pragma unroll
  for(int tl=0;tl<4;++tl){ glds16(ksrc+(long)tl*KVBLK*KVP,(unsigned)__builtin_amdgcn_readfirstlane(lds0+tl*SLOTB+wid*1024)); glds16(vsrc+(long)tl*KVBLK*KVP,(unsigned)__builtin_amdgcn_readfirstlane(lds0+4*SLOTB+tl*SLOTB+wid*1024)); }
  if(tid<256)((__attribute__((address_space(3))) float*)(shm+RES_GT_OFF))[tid]=-sl2*(float)(256*blk+tid);
  asm volatile("s_waitcnt vmcnt(0) lgkmcnt(0)\n\ts_barrier":::"memory");
}
__device__ __forceinline__ bool gate_better(float g,int i,float cg,int ci){ return g>cg||(g==cg&&i<ci); }
#define T3_INSERT(g_,i_) do{ const float tg_=(g_); const int ti_=(i_); const bool b0_=gate_better(tg_,ti_,g0,i0), b1_=gate_better(tg_,ti_,g1,i1), b2_=gate_better(tg_,ti_,g2,i2); \
    const float n2_=b1_?g1:(b2_?tg_:g2); const int m2_=b1_?i1:(b2_?ti_:i2); const float n1_=b0_?g0:(b1_?tg_:g1); const int m1_=b0_?i0:(b1_?ti_:i1); \
    g0=b0_?tg_:g0; i0=b0_?ti_:i0; g1=n1_; i1=m1_; g2=n2_; i2=m2_; }while(0)
__device__ __forceinline__ void moba_route_lists(const bf16*Qw0,int QP,int qb,float sl2,float thr,unsigned*cnt,unsigned*list,unsigned*ent,const char*shm){
  int tid_=threadIdx.x; asm volatile("":"+v"(tid_)); const int tid=tid_,lane=tid&63,r32=lane&31,hi=lane>>5; const int wid=__builtin_amdgcn_readfirstlane(tid>>6);
  const lds_fptr km=(lds_fptr)((lds_cptr)shm+KM_OFF)+r32*64+8*hi;
  const bf16*Qw=Qw0+(long)(wid*QBLK+r32)*QP+hi*8;
  f32x16 gate=f32x16{};
  #pragma unroll
  for(int d0=0;d0<4;++d0){
    const bf16x8 qf=*reinterpret_cast<const bf16x8*>(Qw+d0*16);
    const f32x4 k0=*(const __attribute__((address_space(3))) f32x4*)(km+16*d0), k1=*(const __attribute__((address_space(3))) f32x4*)(km+16*d0+4);
    u32x4 ah,al;
    #pragma unroll
    for(int c=0;c<2;++c){ const f32x4 kv=c?k1:k0;
      const unsigned h01=cvtpk_s(kv[0],kv[1]), h23=cvtpk_s(kv[2],kv[3]);
      const float r0=kv[0]-__uint_as_float(h01<<16), r1=kv[1]-__uint_as_float(h01&0xffff0000u), r2=kv[2]-__uint_as_float(h23<<16), r3=kv[3]-__uint_as_float(h23&0xffff0000u);
      ah[2*c]=h01; ah[2*c+1]=h23; al[2*c]=cvtpk_s(r0,r1); al[2*c+1]=cvtpk_s(r2,r3); }
    gate=__builtin_amdgcn_mfma_f32_32x32x16_bf16(__builtin_bit_cast(bf16x8,ah),qf,gate,0,0,0);
    gate=__builtin_amdgcn_mfma_f32_32x32x16_bf16(__builtin_bit_cast(bf16x8,al),qf,gate,0,0,0);
  }
  float g0=-INFINITY,g1=-INFINITY,g2=-INFINITY; int i0=64,i1=64,i2=64;
  #pragma unroll
  for(int r=0;r<16;++r){ const int blk=crow(r,hi); const bool ok=blk<qb; T3_INSERT(ok?gate[r]:-INFINITY, ok?blk:64); }
  { const float p0=__shfl_xor(g0,32),p1=__shfl_xor(g1,32),p2=__shfl_xor(g2,32); const int j0=__shfl_xor(i0,32),j1=__shfl_xor(i1,32),j2=__shfl_xor(i2,32);
    T3_INSERT(p0,j0); T3_INSERT(p1,j1); T3_INSERT(p2,j2); }
  const int t=256*qb+wid*QBLK+r32; unsigned bits=0u;
  if(i0<64&&sl2*(float)(t-(256*i0+255))<=thr)bits|=1u<<i0;
  if(i1<64&&sl2*(float)(t-(256*i1+255))<=thr)bits|=1u<<i1;
  if(i2<64&&sl2*(float)(t-(256*i2+255))<=thr)bits|=1u<<i2;
  if(hi)bits=0u;
  unsigned mycnt=0u;
  for(int j=0;j<qb;++j){ const unsigned long long m=__ballot((bits>>j)&1u); if(lane==j)mycnt=(unsigned)__builtin_popcountll(m); }
  unsigned base=0u; if(lane<qb&&mycnt>0u)base=__hip_atomic_fetch_add(cnt+lane,mycnt,__ATOMIC_RELAXED,__HIP_MEMORY_SCOPE_AGENT);
  unsigned e0=0u,e1=0u,e2=0u,k=0u;
  for(int j=0;j<qb;++j){ const unsigned long long m=__ballot((bits>>j)&1u); const unsigned bj=(unsigned)__builtin_amdgcn_readlane((int)base,j);
    if((bits>>j)&1u){ const unsigned pos=bj+(unsigned)__builtin_popcountll(m&((1ull<<lane)-1ull)); list[(size_t)j*8192+pos]=(unsigned)t; const unsigned v=((unsigned)j<<16)|pos;
      if(k==0u)e0=v; else if(k==1u)e1=v; else e2=v; ++k; } }
  if(!hi){ const u32x4 en={e0,e1,e2,k}; *(u32x4*)(ent+(size_t)t*4)=en; }
}
#undef SBAR
#undef WAIT_BAR
}

constexpr int NWAVES = 8;
constexpr int RING_OFF = 0, RING_BYTES = 131072;
constexpr int LDSCTL_OFF = RING_BYTES, MISC_OFF = LDSCTL_OFF + 320;
constexpr int LDS_BYTES = 147456;
static_assert(attn_body::ATTN_LDS_END <= RING_BYTES, "attention LDS map");
constexpr int CW_TMO = 0, CW_BAR = 4096, CW_QUEUE = 8192;
constexpr int CW_NMAX = 24576;
constexpr int CW_CNT = 16384;
constexpr size_t OUT_LIST = 68 * MiB;
constexpr size_t WS_PARTB = 408 * MiB, WS_ML = 476 * MiB, WS_ENT = 485 * MiB, WS_END3 = 492 * MiB;
constexpr int PART_PER_BH = 23040;
constexpr size_t WS_QN = 404 * MiB, WS_KN = WS_QN + 1536 * 1024, WS_END2 = 407 * MiB;
constexpr size_t WL_STRIDE = 24 * MiB, WL_IN = 0, WL_OUT = 5632 * 1024, WL_GU = WL_OUT + 2 * MiB, WL_DN = WL_GU + 11 * MiB, W_MKV = 96 * MiB;
static_assert(WL_DN + (size_t)1024 * 2816 * 2 <= WL_STRIDE && WS_W + W_MKV + 4 * MiB <= WS_HB, "weight map");
constexpr int NPROJ_FOX = 2560, NPROJ_MOBA = 2560;
constexpr int N_PHASES = 30;

#define GAS __attribute__((address_space(1)))
#define LAS __attribute__((address_space(3)))
typedef unsigned v4u __attribute__((ext_vector_type(4)));
typedef float f32x4 __attribute__((ext_vector_type(4)));
typedef GAS unsigned gu32;
#define RLX_AGENT __ATOMIC_RELAXED, __HIP_MEMORY_SCOPE_AGENT
#define LDS_WAIT() asm volatile("s_waitcnt lgkmcnt(0)" ::: "memory")
#define VM_WAIT() asm volatile("s_waitcnt vmcnt(0)" ::: "memory")
__device__ __forceinline__ unsigned pk2(float lo, float hi) { return (unsigned)f2bf(lo) | ((unsigned)f2bf(hi) << 16); }

#define XB_TMO      128
#define XB_XCNT(j)  (256  + 64 * (j))
#define XB_XSUB(j)  (1280 + 64 * (j))
#define XB_XGEN(j)  (2304 + 64 * (j))
#define XB_TOP      3328
#define XB_TOPGEN   3392
#define XCD_BAR_WORDS 3456
#define XB_SPIN_CAP (1u << 18)

__device__ __forceinline__ unsigned xb_ld(unsigned* p)              { return __hip_atomic_load(p, __ATOMIC_RELAXED, __HIP_MEMORY_SCOPE_AGENT); }
__device__ __forceinline__ unsigned xb_add(unsigned* p, unsigned v) { return __hip_atomic_fetch_add(p, v, __ATOMIC_RELAXED, __HIP_MEMORY_SCOPE_AGENT); }
__device__ __forceinline__ unsigned xb_xcc_id() { return (unsigned)__builtin_amdgcn_s_getreg((3 << 11) | 20) & 0xFu; }
#define XB_SPIN(cond, bar) do { unsigned _sp = 0; while (cond) { __builtin_amdgcn_s_sleep(1); \
    if ((++_sp & 255u) == 0u) { if (xb_ld(&(bar)[XB_TMO])) break; if (_sp > XB_SPIN_CAP) { atomicAdd(&(bar)[XB_TMO], 1u); break; } } } } while (0)

struct XcdBarrier {
    unsigned* bar; unsigned x;
    volatile LAS unsigned* st;
};

__device__ __forceinline__ XcdBarrier xcd_barrier_post(unsigned* bar, volatile LAS unsigned* st) {
    XcdBarrier b; b.bar = bar; b.x = xb_xcc_id(); b.st = st;
    if (threadIdx.x == 0) (void)xb_add(&bar[XB_XCNT(b.x)], 1u);
    return b;
}
__device__ __forceinline__ void xcd_barrier_complete(unsigned* bar, unsigned x, unsigned& nloc, unsigned& nx) {
    const unsigned G = gridDim.x * gridDim.y * gridDim.z;
    unsigned sum, cnt, mine, sp = 0u;
    for (;;) {
        sum = 0u; cnt = 0u; mine = 0u;
#pragma unroll
        for (unsigned j = 0; j < 16; ++j) { const unsigned c = xb_ld(&bar[XB_XCNT(j)]); sum += c; cnt += (c > 0u) ? 1u : 0u; mine = (j == x) ? c : mine; }
        if (sum == G) break;
        __builtin_amdgcn_s_sleep(1);
        if ((++sp & 255u) == 0u) { if (xb_ld(&bar[XB_TMO])) break; if (sp > XB_SPIN_CAP) { atomicAdd(&bar[XB_TMO], 1u); break; } }
    }
    nloc = mine > 0u ? mine : 1u; nx = cnt > 0u ? cnt : 1u;
}

__device__ __forceinline__ void xcd_barrier(const XcdBarrier& b) {
    asm volatile("s_waitcnt vmcnt(0)" ::: "memory");
    __syncthreads();
    if (threadIdx.x == 0) {
        unsigned* bar = b.bar; asm volatile("" : "+s"(bar));
        __builtin_amdgcn_s_waitcnt(0);
        unsigned nloc = b.st[0], nx = b.st[1];
        if (nloc == 0u) { xcd_barrier_complete(bar, b.x, nloc, nx); b.st[0] = nloc; b.st[1] = nx; }
        const unsigned old = xb_add(&bar[XB_XSUB(b.x)], 1u);
        const unsigned gen = old / nloc;
        if (old + 1u == (gen + 1u) * nloc) {
            __builtin_amdgcn_fence(__ATOMIC_RELEASE, "agent");
            asm volatile("s_waitcnt vmcnt(0)" ::: "memory");
            const unsigned og = xb_add(&bar[XB_TOP], 1u);
            const unsigned tg = og / nx;
            if (og + 1u == (tg + 1u) * nx) xb_add(&bar[XB_TOPGEN], 1u);
            else XB_SPIN(xb_ld(&bar[XB_TOPGEN]) == tg, bar);
            __builtin_amdgcn_fence(__ATOMIC_ACQUIRE, "agent");
            xb_add(&bar[XB_XGEN(b.x)], 1u);
            asm volatile("s_waitcnt vmcnt(0)" ::: "memory");
        } else {
            XB_SPIN(xb_ld(&bar[XB_XGEN(b.x)]) == gen, bar);
            __builtin_amdgcn_fence(__ATOMIC_ACQUIRE, "agent");
            asm volatile("s_waitcnt vmcnt(0)" ::: "memory");
        }
    }
    __syncthreads();
}


struct Args { const float* in[13]; float* out; unsigned char* ws; int ph_lo, ph_hi, flags, pad; };

__device__ __forceinline__ void conv_item(const float* W, int Nsrc, const float* gain, bf16* WT, int K, int dst_row0, int src0, int nvalid, int k0, LAS float* scr, int lane) {
    float v[32]; const int j = lane & 31;
#pragma unroll
    for (int i = 0; i < 32; ++i) { const int kk = 2 * i + (lane >> 5); v[i] = (j < nvalid) ? W[(size_t)(k0 + kk) * Nsrc + src0 + j] : 0.f; }
    if (gain) {
#pragma unroll
        for (int i = 0; i < 32; ++i) v[i] *= gain[k0 + 2 * i + (lane >> 5)]; }
#pragma unroll
    for (int i = 0; i < 32; ++i) scr[(2 * i + (lane >> 5)) * 33 + j] = v[i];
    LDS_WAIT(); asm volatile("" ::: "memory");
    const int c = lane & 7;
#pragma unroll
    for (int j = 0; j < 4; ++j) { const int n = (lane >> 3) + 8 * j; const LAS float* s = scr + (8 * c) * 33 + n;
        v4u o; o.x = pk2(s[0 * 33], s[1 * 33]); o.y = pk2(s[2 * 33], s[3 * 33]); o.z = pk2(s[4 * 33], s[5 * 33]); o.w = pk2(s[6 * 33], s[7 * 33]);
        *(GAS v4u*)(WT + (size_t)(dst_row0 + n) * K + k0 + 8 * c) = o; }
    LDS_WAIT(); asm volatile("" ::: "memory");
}

__device__ __forceinline__ void flogit_job(const bf16* hb, const bf16* Wf, const float* ssq, const float* bfg, float* LF, int row0, int lane) {
    typedef short bf16x8v __attribute__((ext_vector_type(8)));
    const int r = lane & 15, kq = lane >> 4;
    const bf16x8v* ap = (const bf16x8v*)(Wf + (size_t)r * D + 8 * kq); const bf16x8v* bp = (const bf16x8v*)(hb + (size_t)(row0 + r) * D + 8 * kq);
    f32x4 acc0 = {0.f, 0.f, 0.f, 0.f}, acc1 = {0.f, 0.f, 0.f, 0.f};
#pragma unroll 8
    for (int kk = 0; kk < D / 32; kk += 2) {
        acc0 = __builtin_amdgcn_mfma_f32_16x16x32_bf16(ap[4 * kk], bp[4 * kk], acc0, 0, 0, 0);
        acc1 = __builtin_amdgcn_mfma_f32_16x16x32_bf16(ap[4 * kk + 4], bp[4 * kk + 4], acc1, 0, 0, 0); }
    const f32x4 p = *(const f32x4*)(ssq + (size_t)(row0 + r) * 16 + 4 * kq);
    float s = (p[0] + p[1]) + (p[2] + p[3]); s += __shfl_xor(s, 16); s += __shfl_xor(s, 32);
    const float rstd = rsqrtf(s * (1.0f / D) + RMS_EPS);
    const int row = row0 + r, b = row >> 13, t = row & 8191;
    if (kq < 3) {
#pragma unroll
        for (int i = 0; i < 4; ++i) { const int h = 4 * kq + i; const float z2 = ((acc0[i] + acc1[i]) * rstd + bfg[h]) * LOG2E;
            LF[((size_t)b * NSH + h) * T + t] = fminf(z2, 0.f) - __builtin_amdgcn_logf(1.0f + __builtin_amdgcn_exp2f(-fabsf(z2))); } }
}

struct ConvSrc { const float *w_in_fox, *w_in_moba, *norm_mix, *w_out, *w_gate_up, *norm_ffn, *w_down, *w_mem_kv, *norm_mem; };
constexpr int I_IN = 88 * 16, I_OUT = 32 * 16, I_GU = 176 * 16, I_DN = 32 * 44, I_L = I_IN + I_OUT + I_GU + I_DN, I_MKV = 64 * 16, NITEMS = 4 * I_L + I_MKV;
__device__ __forceinline__ void conv_dispatch(int it, const ConvSrc& cs, unsigned char* ws, LAS float* scr, int lane) {
    const float* w_in_fox = cs.w_in_fox; const float* w_in_moba = cs.w_in_moba; const float* norm_mix = cs.norm_mix; const float* w_out = cs.w_out; const float* w_gate_up = cs.w_gate_up;
    const float* norm_ffn = cs.norm_ffn; const float* w_down = cs.w_down; const float* w_mem_kv = cs.w_mem_kv; const float* norm_mem = cs.norm_mem;
    do {
            if (it < 4 * I_L) {
                const int L = it / I_L; int r = it % I_L; const int j = L >> 1; const bool fox = (L & 1) == 0;
                bf16* wl = (bf16*)(ws + WS_W + (size_t)L * WL_STRIDE);
                if (r < I_IN) { const int nb = r >> 4, kb = r & 15; int src0, nv = 32;
                    if (fox) { if (nb < 72) src0 = 32 * nb; else if (nb < 80) src0 = 2316 + 32 * (nb - 72); else if (nb == 80) { src0 = 2304; nv = 12; } else { src0 = 0; nv = 0; } }
                    else { if (nb < 80) src0 = 32 * nb; else { src0 = 0; nv = 0; } }
                    conv_item(fox ? w_in_fox + (size_t)j * D * FOXP : w_in_moba + (size_t)j * D * MOBAP, fox ? FOXP : MOBAP, norm_mix + (size_t)L * D, (bf16*)((unsigned char*)wl + WL_IN), D, 32 * nb, src0, nv, 64 * kb, scr, lane); break; }
                r -= I_IN;
                if (r < I_OUT) { const int nb = r >> 4, kb = r & 15; conv_item(w_out + (size_t)L * D * D, D, nullptr, (bf16*)((unsigned char*)wl + WL_OUT), D, 32 * nb, 32 * nb, 32, 64 * kb, scr, lane); break; }
                r -= I_OUT;
                if (r < I_GU) { const int nb = r >> 4, kb = r & 15, pn = nb >> 3, rb = nb & 7; const int src0 = (rb < 4) ? 128 * pn + 32 * rb : DFF + 128 * pn + 32 * (rb - 4);
                    conv_item(w_gate_up + (size_t)L * D * 2 * DFF, 2 * DFF, norm_ffn + (size_t)L * D, (bf16*)((unsigned char*)wl + WL_GU), D, 32 * nb, src0, 32, 64 * kb, scr, lane); break; }
                r -= I_GU;
                { const int nb = r / 44, kb = r % 44; conv_item(w_down + (size_t)L * DFF * D, D, nullptr, (bf16*)((unsigned char*)wl + WL_DN), DFF, 32 * nb, 32 * nb, 32, 64 * kb, scr, lane); }
            } else {
                const int r = it - 4 * I_L, nb = r >> 4, kb = r & 15, L = nb >> 4;
                conv_item(w_mem_kv + (size_t)L * D * 512, 512, norm_mem + (size_t)L * D, (bf16*)(ws + WS_W + W_MKV), D, 32 * nb, 32 * (nb & 15), 32, 64 * kb, scr, lane);
            }
    } while (0);
}

__global__ void __launch_bounds__(NWAVES * 64, 2) mega_fwd(Args args) {
    extern __shared__ __attribute__((aligned(16))) unsigned char lds[];
    LAS unsigned char* const ldsl = (LAS unsigned char*)lds;
    volatile LAS unsigned* const MISC = (volatile LAS unsigned*)(ldsl + MISC_OFF);
    const int G = gridDim.x; const int bx = blockIdx.x; const int vcu = (G % 8 == 0) ? (bx % 8) * (G / 8) + bx / 8 : bx;
    unsigned char* const ws = args.ws;
    gu32* const ctl = (gu32*)(ws + WS_CTL);
    const float* x = args.in[0]; const float* mem = args.in[1]; const float* norm_mix = args.in[2]; const float* norm_mem = args.in[3]; const float* norm_ffn = args.in[4]; const float* norm_final = args.in[5];
    const float* w_in_fox = args.in[6]; const float* b_fgate = args.in[7]; const float* w_in_moba = args.in[8]; const float* w_mem_kv = args.in[9]; const float* w_out = args.in[10];
    const float* w_gate_up = args.in[11]; const float* w_down = args.in[12];
    float* const out = args.out;
    float* const SSQA = (float*)(ws + WS_SSQA); float* const SSQB = (float*)(ws + WS_SSQB); float* const RSTDM = (float*)(ws + WS_RSTDM); float* const LF = (float*)(ws + WS_LF);
    bf16* const MKV = (bf16*)(ws + WS_MKV); bf16* const MEMB = (bf16*)(ws + WS_MEMB); bf16* const HB = (bf16*)(ws + WS_HB);
    bf16* const Qb = (bf16*)(ws + WS_Q); bf16* const Kb = (bf16*)(ws + WS_K); bf16* const Vb = (bf16*)(ws + WS_V); bf16* const QMb = (bf16*)(ws + WS_QM); bf16* const HEADS = (bf16*)(ws + WS_HEADS); bf16* const ACT = (bf16*)(ws + WS_ACT);
    for (int u = threadIdx.x; u < (LDS_BYTES - LDSCTL_OFF) / 4; u += NWAVES * 64) ((LAS unsigned*)(ldsl + LDSCTL_OFF))[u] = 0u;
    __syncthreads();
    const int lo = args.ph_lo, hi = args.ph_hi;
    XcdBarrier bar; bar.bar = (unsigned*)(ctl + CW_BAR); bar.x = 0; bar.st = nullptr;
    if (hi - lo > 1) bar = xcd_barrier_post((unsigned*)(ctl + CW_BAR), MISC + 8);
#define IN(k) (lo <= (k) && (k) < hi)
#define SEAM(k) do { if (IN(k) && IN((k) + 1)) xcd_barrier(bar); } while (0)

    if (IN(0)) {
        int tid_ = threadIdx.x; asm volatile("" : "+v"(tid_)); const int lane = tid_ & 63, wave = __builtin_amdgcn_readfirstlane(tid_ >> 6);
        LAS float* scr = (LAS float*)(ldsl + RING_OFF + wave * 16384);
        const int gw = vcu * NWAVES + wave, NGW = G * NWAVES;
        const ConvSrc cs{w_in_fox, w_in_moba, norm_mix, w_out, w_gate_up, norm_ffn, w_down, w_mem_kv, norm_mem};
        for (int it = gw; it < NITEMS; it += NGW) { if (it >= I_IN && it < 4 * I_L) continue; conv_dispatch(it, cs, ws, scr, lane); }
        for (int m = gw; m < M + MROWS; m += NGW) {
            const bool ismem = m >= M; const int row = ismem ? m - M : m;
            const GAS f32x4* xr = (const GAS f32x4*)((ismem ? mem : x) + (size_t)row * D) + lane;
            f32x4 v[4]; float s = 0.f;
#pragma unroll
            for (int j = 0; j < 4; ++j) { v[j] = xr[64 * j]; s += (v[j].x * v[j].x + v[j].y * v[j].y) + (v[j].z * v[j].z + v[j].w * v[j].w); }
            s = wave_sum(s);
            GAS unsigned long long* o8 = (GAS unsigned long long*)((ismem ? MEMB : HB) + (size_t)row * D) + lane;
#pragma unroll
            for (int j = 0; j < 4; ++j) o8[64 * j] = (unsigned long long)pk2(v[j].x, v[j].y) | ((unsigned long long)pk2(v[j].z, v[j].w) << 32);
            if (ismem) { if (lane == 0) RSTDM[row] = rsqrtf(s * (1.f / D) + RMS_EPS); }
            else if (lane < 16) SSQA[(size_t)row * 16 + lane] = (lane == 0) ? s : 0.f;
        }
    }
    SEAM(0);

    for (int L = 0; L < DEPTH; ++L) {
        const int pbase = 1 + 7 * L; const bool fox = (L & 1) == 0; const int j = L >> 1;
        const unsigned char* wl = ws + WS_W + (size_t)L * WL_STRIDE;
        float* const KMEAN = (float*)(ws + WS_KMEAN + (size_t)j * KMEAN_STRIDE);
        if (IN(pbase)) {
            pg8::Gemm g{(const pg8::bf16_t*)HB, (const pg8::bf16_t*)(wl + WL_IN), M, fox ? NPROJ_FOX : NPROJ_MOBA, D}; pg8::StaticOrder S; S.init(M, g.N, G, bx);
            pg8::EpiProj E{Qb, Kb, Vb, QMb, fox ? nullptr : KMEAN, SSQA, (float*)(ctl + CW_NMAX + 256 * L)};
            pg8::gemm_phase<pg8::EpiProj, pg8::StaticOrder, true, true>(ldsl + RING_OFF, g, S, E);
            if (fox) { int t3_ = threadIdx.x; asm volatile("" : "+v"(t3_)); const int wv3 = __builtin_amdgcn_readfirstlane(t3_ >> 6);
                for (int jb = vcu * NWAVES + wv3; jb < M / 16; jb += G * NWAVES) flogit_job(HB, (const bf16*)(wl + WL_IN) + (size_t)2560 * D, SSQA, b_fgate + (size_t)j * NSH, LF, 16 * jb, t3_ & 63); }
            if (L == 0) {
                pg8::Gemm g2{(const pg8::bf16_t*)MEMB, (const pg8::bf16_t*)(ws + WS_W + W_MKV), MROWS, 2048, D}; pg8::StaticOrder S2; S2.init(MROWS, 2048, G, (G == 256) ? ((bx + 128) & 255) : bx);
                pg8::EpiMkv E2{MKV, RSTDM};
                pg8::gemm_phase<pg8::EpiMkv, pg8::StaticOrder, true, true>(ldsl + RING_OFF, g2, S2, E2);
            }
        }
        SEAM(pbase);
#define ATT_SETUP(sub) \
            char* const shm = (char*)lds + RING_OFF; \
            int tid_ = threadIdx.x; asm volatile("" : "+v"(tid_)); \
            if (tid_ < NSH) { const int h_ = tid_; int rank = 0; \
                if (fox) { const float bh_ = b_fgate[(size_t)j * NSH + h_]; for (int k = 0; k < NSH; ++k) { const float bk = b_fgate[(size_t)j * NSH + k]; rank += (bk > bh_ || (bk == bh_ && k < h_)) ? 1 : 0; } } \
                else rank = NSH - 1 - h_; \
                MISC[16 + rank] = (unsigned)h_; } \
            __syncthreads(); \
            gu32* const qctr = ctl + CW_QUEUE + 64 * (3 * L + (sub)); \
            int prev_bh = -1; (void)prev_bh; const int wv = __builtin_amdgcn_readfirstlane(tid_ >> 6); (void)wv; bool first_ = true
#define DEQ(var) do { if (first_) { first_ = false; var = bx; } else { if (tid_ == 0) MISC[0] = (unsigned)G + __hip_atomic_fetch_add(qctr, 1u, RLX_AGENT); __syncthreads(); var = __builtin_amdgcn_readfirstlane((int)MISC[0]); __syncthreads(); } } while (0)
        unsigned* const CNTL = (unsigned*)(ctl + CW_CNT + 2048 * j);
        unsigned* const LIST = (unsigned*)((unsigned char*)out + OUT_LIST); unsigned* const ENT = (unsigned*)(ws + WS_ENT); float* const MLB = (float*)(ws + WS_ML);
#define PART_BH(bh) ((bh) < 24 ? (bf16*)out + (size_t)(bh) * PART_PER_BH * HD : (bf16*)(ws + WS_PARTB) + (size_t)((bh) - 24) * PART_PER_BH * HD)
        if (!fox && IN(pbase + 1)) {
            ATT_SETUP(0); float thr = 0.f;
            for (int p = bx; p < 768; p += G) {
                const int hr = p >> 6, b = (p >> 4) & 3, s = p & 15, h = __builtin_amdgcn_readfirstlane((int)MISC[16 + hr]), bh = b * NSH + h;
                const float sl2 = exp2f(-8.0f * (float)(h + 1) / (float)NSH) * LOG2E;
                __syncthreads();
                attn_body::build_tabs_moba(sl2, KMEAN + (size_t)b * NBLK * SELFW + h * HD, shm); thr = attn_body::thr_from_nmax((const float*)(ctl + CW_NMAX + 256 * L) + 4 * bh);
                for (int k = 0; k < 2; ++k) { const int qb = k ? 31 - s : s;
                    attn_body::moba_route_lists(Qb + ((size_t)b * T + (size_t)qb * 256) * SELFW + h * HD, SELFW, qb, sl2, attn_body::skip_eff(thr), CNTL + bh * 32, LIST + (size_t)bh * 31 * 8192, ENT + (size_t)bh * 8192 * 4, shm); }
            }
        }
        if (!fox) SEAM(pbase + 1);
        if (!fox && IN(pbase + 2)) {
            ATT_SETUP(1);
            volatile LAS unsigned* const SP = (volatile LAS unsigned*)(ldsl + RING_OFF + attn_body::KM_OFF); volatile LAS unsigned* const RP = (volatile LAS unsigned*)(ldsl + RING_OFF + attn_body::SEL_OFF);
            volatile LAS unsigned* const CA = (volatile LAS unsigned*)(ldsl + RING_OFF + attn_body::ALLT_OFF); volatile LAS unsigned* const BA = CA + 1536;
            for (int idx = tid_; idx < 1536; idx += NWAVES * 64) { const int hb_ = idx >> 5, jj = idx & 31, bh_ = (hb_ & 3) * NSH + (int)MISC[16 + (hb_ >> 2)];
                const unsigned c = (jj < 31) ? __hip_atomic_load(CNTL + bh_ * 32 + jj, __ATOMIC_RELAXED, __HIP_MEMORY_SCOPE_AGENT) : 0u; CA[idx] = c; SP[idx] = (c + 1023u) >> 10; }
            __syncthreads();
            if (tid_ < 48) { unsigned run = 0, eb = 0; for (int jj = 0; jj < 32; ++jj) { BA[tid_ * 32 + jj] = eb; eb += CA[tid_ * 32 + jj]; run += SP[tid_ * 32 + jj]; SP[tid_ * 32 + jj] = run; } RP[tid_ + 1] = run; }
            __syncthreads();
            if (tid_ == 0) { unsigned run = 0; RP[0] = 0u; for (int r = 1; r <= 48; ++r) { run += RP[r]; RP[r] = run; } }
            __syncthreads();
            const int nslots = __builtin_amdgcn_readfirstlane((int)RP[48]);
            for (;;) { int i; DEQ(i); if (i >= nslots) break;
                int hb = 0; for (int st = 32; st > 0; st >>= 1) { const int r = hb + st; if (r < 48 && (int)RP[r] <= i) hb = r; }
                hb = __builtin_amdgcn_readfirstlane(hb); const int li = i - __builtin_amdgcn_readfirstlane((int)RP[hb]);
                int jb = 0; for (int st = 16; st > 0; st >>= 1) { const int r = jb + st; if (r < 32 && (int)SP[hb * 32 + r - 1] <= li) jb = r; }
                jb = __builtin_amdgcn_readfirstlane(jb); const int g_ = li - (jb ? __builtin_amdgcn_readfirstlane((int)SP[hb * 32 + jb - 1]) : 0);
                const int hr = hb >> 2, b = hb & 3, h = __builtin_amdgcn_readfirstlane((int)MISC[16 + hr]), bh = b * NSH + h;
                const float sl2 = exp2f(-8.0f * (float)(h + 1) / (float)NSH) * LOG2E;
                const int cnt = (int)CA[hb * 32 + jb], basej = (int)BA[hb * 32 + jb];
                const int cntu = __builtin_amdgcn_readfirstlane(cnt), baseu = __builtin_amdgcn_readfirstlane(basej);
                if (1024 * g_ >= cntu) continue;
                const bf16* kh = Kb + (size_t)b * T * SELFW + h * HD; const bf16* vh = Vb + (size_t)b * T * SELFW + h * HD;
                attn_body::load_block_kv(kh, vh, SELFW, jb, sl2, shm);
                const float thrb = attn_body::thr_from_nmax((const float*)(ctl + CW_NMAX + 256 * L) + 4 * bh), m0b = (thrb - 150.0f) * 0.5f;
                const bool stb = __builtin_amdgcn_readfirstlane(thrb < 210.0f ? 1 : 0) != 0;
                const int nw = (cntu + 31) >> 5, wend = (32 * g_ + 32 < nw) ? 32 * g_ + 32 : nw;
                for (int wc = 32 * g_ + wv; wc < wend; wc += NWAVES) {
                    const int e0 = baseu + 32 * wc; attn_body::AttnAux ax{LIST + ((size_t)bh * 31 + jb) * 8192 + 32 * wc, MLB + ((size_t)bh * PART_PER_BH + e0) * 2, nullptr, nullptr, nullptr, sl2, (cntu - 32 * wc) < 32 ? (cntu - 32 * wc) : 32, 0, 0};
                    if (stb) attn_body::attn_unit<3, 24, true, true>(Qb + (size_t)b * T * SELFW + h * HD, SELFW, kh, vh, SELFW, PART_BH(bh) + (size_t)e0 * HD, HD, 4, 0, shm, ax, m0b);
                    else attn_body::attn_unit<3, 24, true>(Qb + (size_t)b * T * SELFW + h * HD, SELFW, kh, vh, SELFW, PART_BH(bh) + (size_t)e0 * HD, HD, 4, 0, shm, ax);
                }
            }
        }
        if (!fox) SEAM(pbase + 2);
        if (IN(pbase + 3)) {
            ATT_SETUP(2);
            if (!fox) {
                volatile LAS unsigned* const CA = (volatile LAS unsigned*)(ldsl + RING_OFF + attn_body::ALLT_OFF); volatile LAS unsigned* const BA = CA + 1536;
                for (int idx = tid_; idx < 1536; idx += NWAVES * 64) { const int hb_ = idx >> 5, jj = idx & 31, bh_ = (hb_ & 3) * NSH + (int)MISC[16 + (hb_ >> 2)];
                    CA[idx] = (jj < 31) ? __hip_atomic_load(CNTL + bh_ * 32 + jj, __ATOMIC_RELAXED, __HIP_MEMORY_SCOPE_AGENT) : 0u; }
                __syncthreads();
                if (tid_ < 48) { unsigned eb = 0; for (int jj = 0; jj < 32; ++jj) { BA[tid_ * 32 + jj] = eb; eb += CA[tid_ * 32 + jj]; } }
                __syncthreads();
            }
            const int nself = (args.flags & 1) ? (fox ? 768 : 1536) : 0, nmem = (args.flags & 2) ? 256 : 0; float thr = 0.f;
            const int nconv = (L == 0) ? (4 * I_L - I_IN + 63) / 64 : 0;
            const ConvSrc cs{w_in_fox, w_in_moba, norm_mix, w_out, w_gate_up, norm_ffn, w_down, w_mem_kv, norm_mem};
            int si_ = bx;
            for (;;) { int i;
                if (fox) { DEQ(i); } else { i = si_; si_ += G; __syncthreads(); }
                if (i >= nself + nmem + nconv) break;
                if (i >= nself + nmem) { LAS float* scr = (LAS float*)(ldsl + RING_OFF + wv * 16384);
                    int tc_ = threadIdx.x; asm volatile("" : "+v"(tc_));
                    for (int k = 0; k < 8; ++k) { const int it = I_IN + (i - nself - nmem) * 64 + wv * 8 + k; if (it < 4 * I_L) conv_dispatch(it, cs, ws, scr, tc_ & 63); }
                    prev_bh = -1; continue; }
                if (i < nself && fox) {
                    const int hr = i >> 6, b = (i >> 4) & 3, s = i & 15, h = __builtin_amdgcn_readfirstlane((int)MISC[16 + hr]), bh = b * NSH + h;
                    if (bh != prev_bh) { prev_bh = bh; attn_body::build_gtab_fox(LF + (size_t)bh * T, shm); thr = attn_body::thr_from_nmax((const float*)(ctl + CW_NMAX + 256 * L) + 4 * bh); }
                    for (int k = 0; k < 2; ++k) { const int qb = k ? 31 - s : s; const size_t row0 = (size_t)b * T + (size_t)qb * 256;
                        const int t0 = attn_body::tile_start(shm, 4 * qb + 4, attn_body::skip_eff(thr));
                        if (__builtin_amdgcn_readfirstlane(thr < 210.0f ? 1 : 0)) attn_body::attn_unit<0, 24, false, true>(Qb + row0 * SELFW + h * HD, SELFW, Kb + (size_t)b * T * SELFW + h * HD, Vb + (size_t)b * T * SELFW + h * HD, SELFW, HEADS + row0 * D + h * HD, D, 4 * qb + 4, t0, shm, attn_body::AttnAux{}, (thr - 150.0f) * 0.5f);
                        else attn_body::attn_unit<0, 24>(Qb + row0 * SELFW + h * HD, SELFW, Kb + (size_t)b * T * SELFW + h * HD, Vb + (size_t)b * T * SELFW + h * HD, SELFW, HEADS + row0 * D + h * HD, D, 4 * qb + 4, t0, shm);
                    }
                } else if (i < nself) {
                    const int hr = i >> 7, b = (i >> 5) & 3, qb = ((i & 31) + (i >> 5)) & 31, h = __builtin_amdgcn_readfirstlane((int)MISC[16 + hr]), bh = b * NSH + h; const size_t row0 = (size_t)b * T + (size_t)qb * 256;
                    const float sl2 = exp2f(-8.0f * (float)(h + 1) / (float)NSH) * LOG2E;
                    const bf16* kh = Kb + (size_t)b * T * SELFW + h * HD; const bf16* vh = Vb + (size_t)b * T * SELFW + h * HD;
                    attn_body::load_block_kv(kh, vh, SELFW, qb, sl2, shm);
                    attn_body::AttnAux ax{nullptr, nullptr, ENT + ((size_t)bh * 8192 + (size_t)qb * 256) * 4, PART_BH(bh), MLB + (size_t)bh * PART_PER_BH * 2, sl2, 0, attn_body::ALLT_OFF + (1536 + (hr * 4 + b) * 32) * 4, 0};
                    const float thro = attn_body::thr_from_nmax((const float*)(ctl + CW_NMAX + 256 * L) + 4 * bh);
                    if (__builtin_amdgcn_readfirstlane(thro < 210.0f ? 1 : 0)) attn_body::attn_unit<4, 24, true, true>(Qb + row0 * SELFW + h * HD, SELFW, kh, vh, SELFW, HEADS + row0 * D + h * HD, D, 4, 0, shm, ax, (thro - 150.0f) * 0.5f);
                    else attn_body::attn_unit<4, 24, true>(Qb + row0 * SELFW + h * HD, SELFW, kh, vh, SELFW, HEADS + row0 * D + h * HD, D, 4, 0, shm, ax);
                } else {
                    const int u = i - nself, b = u >> 6, hm = (u >> 4) & 3, g2 = u & 15;
                    const bf16* kh = MKV + (size_t)b * NMEM * 2048 + L * 512 + hm * HD;
                    attn_body::load_block_kv(kh, kh + 256, 2048, 0, 0.f, shm); prev_bh = -1;
                    for (int k = 0; k < 2; ++k) { const size_t row0 = (size_t)b * T + (size_t)(2 * g2 + k) * 256;
                        attn_body::attn_unit<2, 8, true>(QMb + row0 * MEMW + hm * HD, MEMW, kh, kh + 256, 2048, HEADS + row0 * D + SELFW + hm * HD, D, 4, 0, shm); }
                }
            }
        }
        SEAM(pbase + 3);
#undef ATT_SETUP
#undef DEQ
#undef PART_BH
        if (IN(pbase + 4)) {
            pg8::Gemm g{(const pg8::bf16_t*)HEADS, (const pg8::bf16_t*)(wl + WL_OUT), M, D, D}; pg8::StaticOrder S; S.init(M, D, G, bx);
            pg8::EpiRes E{HB, SSQB};
            pg8::gemm_phase<pg8::EpiRes, pg8::StaticOrder, true, true>(ldsl + RING_OFF, g, S, E);
        }
        SEAM(pbase + 4);
        if (IN(pbase + 5)) {
            pg8::Gemm g{(const pg8::bf16_t*)HB, (const pg8::bf16_t*)(wl + WL_GU), M, 2 * DFF, D}; pg8::StaticOrder S; S.init(M, 2 * DFF, G, bx);
            pg8::EpiSwi E{ACT, SSQB};
            pg8::gemm_phase<pg8::EpiSwi, pg8::StaticOrder, true, true>(ldsl + RING_OFF, g, S, E);
        }
        SEAM(pbase + 5);
        if (IN(pbase + 6)) {
            pg8::Gemm g{(const pg8::bf16_t*)ACT, (const pg8::bf16_t*)(wl + WL_DN), M, D, DFF}; pg8::StaticOrder S; S.init(M, D, G, bx);
            pg8::EpiRes E{HB, SSQA};
            pg8::gemm_phase<pg8::EpiRes, pg8::StaticOrder, true, true>(ldsl + RING_OFF, g, S, E);
        }
        SEAM(pbase + 6);
    }
    if (IN(29)) {
        int tid_ = threadIdx.x; asm volatile("" : "+v"(tid_)); const int lane = tid_ & 63, wave = __builtin_amdgcn_readfirstlane(tid_ >> 6);
        const int gw = vcu * NWAVES + wave, NGW = G * NWAVES;
        const unsigned poison = __hip_atomic_load((gu32*)((unsigned*)(ctl + CW_BAR) + XB_TMO), RLX_AGENT);
        for (int m = gw; m < M; m += NGW) {
            float s = (lane < 16) ? SSQA[(size_t)m * 16 + lane] : 0.f; s = wave_sum(s);
            float rstd = rsqrtf(s * (1.f / D) + RMS_EPS); if (poison) rstd = __builtin_nanf("");
            GAS f32x4* p = (GAS f32x4*)(out + (size_t)m * D) + lane; const GAS f32x4* g4 = (const GAS f32x4*)norm_final + lane;
            const GAS unsigned long long* hp = (const GAS unsigned long long*)(HB + (size_t)m * D) + lane;
#pragma unroll
            for (int jj = 0; jj < 4; ++jj) { const unsigned long long w = hp[64 * jj]; const unsigned lo_ = (unsigned)w, hi_ = (unsigned)(w >> 32);
                f32x4 v = {__uint_as_float(lo_ << 16), __uint_as_float(lo_ & 0xffff0000u), __uint_as_float(hi_ << 16), __uint_as_float(hi_ & 0xffff0000u)};
                const f32x4 gg = g4[64 * jj]; v = v * gg * rstd; p[64 * jj] = v; }
        }
    }
#undef IN
#undef SEAM
}

extern "C" void kernel_launch(void* const* d_in, const int* in_sizes, int n_in, void* d_out, int out_size, void* d_ws, size_t ws_size, hipStream_t stream) {
    static int grid = 0;
    if (grid == 0) {
        if (n_in != 13 || in_sizes[0] != M * D || out_size != M * D || ws_size < WS_END3) { fprintf(stderr, "kernel_launch: unexpected shapes (n_in %d, ws %zu)\n", n_in, ws_size); grid = -1; return; }
        int dev = 0, cus = 0, per_cu = 0;
        if (hipGetDevice(&dev) != hipSuccess || hipDeviceGetAttribute(&cus, hipDeviceAttributeMultiprocessorCount, dev) != hipSuccess) { grid = -1; return; }
        if (hipFuncSetAttribute((const void*)mega_fwd, hipFuncAttributeMaxDynamicSharedMemorySize, LDS_BYTES) != hipSuccess) { fprintf(stderr, "kernel_launch: hipFuncSetAttribute failed\n"); grid = -1; return; }
        if (hipOccupancyMaxActiveBlocksPerMultiprocessor(&per_cu, (const void*)mega_fwd, NWAVES * 64, LDS_BYTES) != hipSuccess || per_cu < 1) fprintf(stderr, "kernel_launch: occupancy query reports %d\n", per_cu);
        (void)hipGetLastError();
        grid = cus;
    }
    if (grid < 0) return;
    unsigned char* ws = (unsigned char*)d_ws; float* out = (float*)d_out;
    (void)hipMemsetAsync(ws + WS_CTL, 0, CTL_ZERO_BYTES, stream);
    Args a{};
    for (int i = 0; i < 13; ++i) a.in[i] = (const float*)d_in[i];
    a.out = out; a.ws = ws; a.flags = 3; a.pad = 0;
    a.ph_lo = 0; a.ph_hi = N_PHASES;
    hipLaunchKernelGGL(mega_fwd, dim3(grid), dim3(NWAVES * 64), LDS_BYTES, stream, a);
}
```
